# Optimizing an MI355X kernel written in HIP

```python
import jax, jax.numpy as jnp
from jax import lax
import numpy as np

D_MODEL = 2048
BATCH = 4
SEQ = 4096
DEPTH = 2

GRID_W = 64
CTX_LEN = 256
Q_BLOCK = 128
ROPE_THETA = 10000.0
NORM_EPS = 1e-6

A_HEAD_DIM = 128
A_HEADS = D_MODEL // 2 // A_HEAD_DIM
A_KV_HEADS = A_HEADS // 4
B_NOPE_DIM = 128
B_ROPE_DIM = 64
B_V_DIM = 128
B_HEADS = D_MODEL // 4 // B_V_DIM
B_Q_RANK = D_MODEL // 4
B_KV_RANK = D_MODEL // 8
C_WINDOWS = (2, 4, 8, 16)
C_GROUPS = 4
C_GROUP_DIM = D_MODEL // 4 // C_GROUPS
C_WIDTH = C_GROUPS * C_GROUP_DIM

A_Q_COLS = A_HEADS * A_HEAD_DIM
A_KV_COLS = A_KV_HEADS * A_HEAD_DIM
IN_SPLITS = (A_Q_COLS, A_KV_COLS, A_KV_COLS, B_Q_RANK, B_KV_RANK, B_ROPE_DIM, C_WIDTH)
IN_COLS = A_Q_COLS + 2 * A_KV_COLS + B_Q_RANK + B_KV_RANK + B_ROPE_DIM + C_WIDTH
MIX_WIDTH = A_Q_COLS + B_HEADS * B_V_DIM + C_WIDTH
D_FF = ((8 * D_MODEL // 3 + 255) // 256) * 256
N_MOD = 9

kernel_name = 'hybrid_dit_prefix_block'


def rmsnorm(x, g):
    xf = x.astype(jnp.float32)
    y = xf * lax.rsqrt(jnp.mean(xf * xf, axis=-1, keepdims=True) + NORM_EPS)
    return (y * g.astype(jnp.float32)).astype(x.dtype)


def axial_rope_tables(rows, cols, dim):
    n = dim // 4
    inv = ROPE_THETA ** (-jnp.arange(n, dtype=jnp.float32) / n)
    ang = jnp.concatenate([rows[:, None] * inv[None, :], cols[:, None] * inv[None, :]], axis=-1)
    return jnp.cos(ang), jnp.sin(ang)


def apply_rope(x, cos, sin):
    half = x.shape[-1] // 2
    x1, x2 = x[..., :half], x[..., half:]
    cs = cos[None, :, None, :].astype(x.dtype)
    sn = sin[None, :, None, :].astype(x.dtype)
    return jnp.concatenate([x1 * cs - x2 * sn, x1 * sn + x2 * cs], axis=-1)


def swiglu(x, w_in, w_out):
    a, b = jnp.split(x @ w_in, 2, axis=-1)
    return (jax.nn.silu(a) * b) @ w_out


def block_attention(q, k, v):
    B, Sq, Hkv, G, dk = q.shape
    scale = dk ** -0.5
    nb = Sq // Q_BLOCK
    qb = jnp.moveaxis(q.reshape(B, nb, Q_BLOCK, Hkv, G, dk), 1, 0)

    def one_block(qblk):
        s = jnp.einsum('bqhgd,bkhd->bhgqk', qblk, k, preferred_element_type=jnp.float32) * scale
        p = jax.nn.softmax(s, axis=-1).astype(v.dtype)
        return jnp.einsum('bhgqk,bkhd->bqhgd', p, v)

    o = lax.map(one_block, qb)
    return jnp.moveaxis(o, 0, 1).reshape(B, Sq, Hkv * G * v.shape[-1])


def split_cols(u):
    idx, acc = [], 0
    for n in IN_SPLITS[:-1]:
        acc += n
        idx.append(acc)
    return jnp.split(u, idx, axis=-1)


def gqa_q(aq, qg, cos, sin):
    B, L, _ = aq.shape
    q = rmsnorm(aq.reshape(B, L, A_HEADS, A_HEAD_DIM), qg)
    if cos is not None:
        q = apply_rope(q, cos, sin)
    return q.reshape(B, L, A_KV_HEADS, A_HEADS // A_KV_HEADS, A_HEAD_DIM)


def gqa_kv(ak, av, kg, cos, sin):
    B, L, _ = ak.shape
    k = rmsnorm(ak.reshape(B, L, A_KV_HEADS, A_HEAD_DIM), kg)
    if cos is not None:
        k = apply_rope(k, cos, sin)
    return k, av.reshape(B, L, A_KV_HEADS, A_HEAD_DIM)


def mla_q(bq, qg, w_uq, cos, sin):
    B, L, _ = bq.shape
    q = (rmsnorm(bq, qg) @ w_uq).reshape(B, L, B_HEADS, B_NOPE_DIM + B_ROPE_DIM)
    q_nope, q_rope = q[..., :B_NOPE_DIM], q[..., B_NOPE_DIM:]
    if cos is not None:
        q_rope = apply_rope(q_rope, cos, sin)
    return jnp.concatenate([q_nope, q_rope], axis=-1)[:, :, :, None, :]


def mla_kv(bkv, bkr, kvg, w_ukv, cos, sin):
    B, L, _ = bkv.shape
    kv = (rmsnorm(bkv, kvg) @ w_ukv).reshape(B, L, B_HEADS, B_NOPE_DIM + B_V_DIM)
    k_nope, v = kv[..., :B_NOPE_DIM], kv[..., B_NOPE_DIM:]
    k_rope = bkr[:, :, None, :]
    if cos is not None:
        k_rope = apply_rope(k_rope, cos, sin)
    k = jnp.concatenate([k_nope, jnp.broadcast_to(k_rope, (B, L, B_HEADS, B_ROPE_DIM))], axis=-1)
    return k, v


def pool_mix(u, w_pool, scale):
    B, L, _ = u.shape
    ug = u.reshape(B, L, C_GROUPS, C_GROUP_DIM)
    cs = jnp.cumsum(ug.astype(jnp.float32), axis=1)
    cs = jnp.concatenate([jnp.zeros_like(cs[:, :1]), cs], axis=1)
    t = jnp.arange(L)
    means = []
    for g, w in enumerate(C_WINDOWS):
        lo = jnp.clip(t - w // 2, 0, L)
        hi = jnp.clip(t - w // 2 + w, 0, L)
        csg = cs[:, :, g]
        means.append((csg[:, hi] - csg[:, lo]) / (hi - lo).astype(jnp.float32)[None, :, None])
    pooled = jnp.stack(means, axis=2).astype(u.dtype) - ug
    y = jnp.einsum('blgc,gcd->blgd', pooled, w_pool)
    return y.reshape(B, L, C_WIDTH) * scale


def token_mixers(u, uc, rope_a, rope_b, p, ctx_queries):
    cos_a, sin_a = rope_a
    cos_b, sin_b = rope_b
    aq, ak, av, bq, bkv, bkr, cu = split_cols(u)
    aqc, akc, avc, bqc, bkvc, bkrc, cuc = split_cols(uc)
    kA_c, vA_c = gqa_kv(akc, avc, p['a_k_g'], None, None)
    kA, vA = gqa_kv(ak, av, p['a_k_g'], cos_a, sin_a)
    yA = block_attention(gqa_q(aq, p['a_q_g'], cos_a, sin_a),
                         jnp.concatenate([kA_c, kA], axis=1), jnp.concatenate([vA_c, vA], axis=1))
    kB_c, vB_c = mla_kv(bkvc, bkrc, p['b_kv_g'], p['b_w_ukv'], None, None)
    kB, vB = mla_kv(bkv, bkr, p['b_kv_g'], p['b_w_ukv'], cos_b, sin_b)
    yB = block_attention(mla_q(bq, p['b_q_g'], p['b_w_uq'], cos_b, sin_b),
                         jnp.concatenate([kB_c, kB], axis=1), jnp.concatenate([vB_c, vB], axis=1))
    yC = pool_mix(cu, p['c_w_pool'], p['c_scale'])
    y = jnp.concatenate([yA, yB, yC], axis=-1)
    if not ctx_queries:
        return y, None
    yAc = block_attention(gqa_q(aqc, p['a_q_g'], None, None), kA_c, vA_c)
    yBc = block_attention(mla_q(bqc, p['b_q_g'], p['b_w_uq'], None, None), kB_c, vB_c)
    yCc = pool_mix(cuc, p['c_w_pool'], p['c_scale'])
    return y, jnp.concatenate([yAc, yBc, yCc], axis=-1)


def modulated_norm(x, g, shift, scale):
    return rmsnorm(x, g) * (1 + scale) + shift


def layer(h, hc, mod, modc, rope_a, rope_b, p, ctx_out):
    m = jnp.split(mod, N_MOD, axis=-1)
    mc = jnp.split(modc, N_MOD, axis=-1)
    ng = p['norm_g']
    h = h + 0.5 * m[2] * swiglu(modulated_norm(h, ng[0], m[0], m[1]), p['ffn1_in'], p['ffn1_out'])
    hc = hc + 0.5 * mc[2] * swiglu(modulated_norm(hc, ng[0], mc[0], mc[1]), p['ffn1_in'], p['ffn1_out'])
    u = modulated_norm(h, ng[1], m[3], m[4]) @ p['w_in']
    uc = modulated_norm(hc, ng[1], mc[3], mc[4]) @ p['w_in']
    y, yc = token_mixers(u, uc, rope_a, rope_b, p, ctx_out)
    h = h + m[5] * (y @ p['w_out'])
    h = h + 0.5 * m[8] * swiglu(modulated_norm(h, ng[2], m[6], m[7]), p['ffn2_in'], p['ffn2_out'])
    if not ctx_out:
        return h, None
    hc = hc + mc[5] * (yc @ p['w_out'])
    hc = hc + 0.5 * mc[8] * swiglu(modulated_norm(hc, ng[2], mc[6], mc[7]), p['ffn2_in'], p['ffn2_out'])
    return h, hc


def setup_inputs(seed: int = 0) -> dict:
    key = jax.random.key(seed)
    ks = jax.random.split(key, 22)
    f32 = jnp.float32
    D = D_MODEL

    def nrm(k, shape, scale):
        return jax.random.normal(k, shape, f32) * scale

    def gain(k, shape):
        return 1.0 + 0.02 * jax.random.normal(k, shape, f32)

    return {
        'x': nrm(ks[0], (BATCH, SEQ, D), 1.0),
        'c': nrm(ks[1], (BATCH, D), 1.0),
        'ctx': nrm(ks[2], (BATCH, CTX_LEN, D), 1.0),
        'c_ctx': nrm(ks[3], (D,), 1.0),
        'w_mod': nrm(ks[4], (DEPTH, D, N_MOD * D), 0.5 * D ** -0.5),
        'b_mod': nrm(ks[5], (DEPTH, N_MOD * D), 0.01),
        'norm_g': gain(ks[6], (DEPTH, 3, D)),
        'ffn1_in': nrm(ks[7], (DEPTH, D, 2 * D_FF), D ** -0.5),
        'ffn1_out': nrm(ks[8], (DEPTH, D_FF, D), D_FF ** -0.5),
        'w_in': nrm(ks[9], (DEPTH, D, IN_COLS), D ** -0.5),
        'a_q_g': gain(ks[10], (DEPTH, A_HEAD_DIM)),
        'a_k_g': gain(ks[11], (DEPTH, A_HEAD_DIM)),
        'b_q_g': gain(ks[12], (DEPTH, B_Q_RANK)),
        'b_kv_g': gain(ks[13], (DEPTH, B_KV_RANK)),
        'b_w_uq': nrm(ks[14], (DEPTH, B_Q_RANK, B_HEADS * (B_NOPE_DIM + B_ROPE_DIM)), B_Q_RANK ** -0.5),
        'b_w_ukv': nrm(ks[15], (DEPTH, B_KV_RANK, B_HEADS * (B_NOPE_DIM + B_V_DIM)), B_KV_RANK ** -0.5),
        'c_w_pool': nrm(ks[16], (DEPTH, C_GROUPS, C_GROUP_DIM, C_GROUP_DIM), C_GROUP_DIM ** -0.5),
        'c_scale': gain(ks[17], (DEPTH, C_WIDTH)),
        'w_out': nrm(ks[18], (DEPTH, MIX_WIDTH, D), MIX_WIDTH ** -0.5),
        'ffn2_in': nrm(ks[19], (DEPTH, D, 2 * D_FF), D ** -0.5),
        'ffn2_out': nrm(ks[20], (DEPTH, D_FF, D), D_FF ** -0.5),
        'final_g': gain(ks[21], (D,)),
    }


def reference(x, c, ctx, c_ctx, w_mod, b_mod, norm_g, ffn1_in, ffn1_out, w_in, a_q_g, a_k_g,
              b_q_g, b_kv_g, b_w_uq, b_w_ukv, c_w_pool, c_scale, w_out, ffn2_in, ffn2_out, final_g):
    B, S, _ = x.shape
    ROWS = S // GRID_W
    rows = jnp.repeat(jnp.arange(ROWS, dtype=jnp.float32), GRID_W)
    cols = jnp.tile(jnp.arange(GRID_W, dtype=jnp.float32), ROWS)
    rope_a = axial_rope_tables(rows, cols, A_HEAD_DIM)
    rope_b = axial_rope_tables(rows, cols, B_ROPE_DIM)
    c_act = jax.nn.silu(c)
    cc_act = jax.nn.silu(c_ctx)
    h, hc = x, ctx
    for i in range(DEPTH):
        p = {
            'norm_g': norm_g[i], 'ffn1_in': ffn1_in[i], 'ffn1_out': ffn1_out[i], 'w_in': w_in[i],
            'a_q_g': a_q_g[i], 'a_k_g': a_k_g[i], 'b_q_g': b_q_g[i], 'b_kv_g': b_kv_g[i],
            'b_w_uq': b_w_uq[i], 'b_w_ukv': b_w_ukv[i], 'c_w_pool': c_w_pool[i], 'c_scale': c_scale[i],
            'w_out': w_out[i], 'ffn2_in': ffn2_in[i], 'ffn2_out': ffn2_out[i],
        }
        mod = (c_act @ w_mod[i] + b_mod[i])[:, None, :]
        modc = (cc_act @ w_mod[i] + b_mod[i])[None, None, :]
        h, hc = layer(h, hc, mod, modc, rope_a, rope_b, p, i < DEPTH - 1)
    return rmsnorm(h, final_g)
```

```cpp
#include <hip/hip_runtime.h>
#include <cstdio>
#include <cstdint>

#define LAS __attribute__((address_space(3)))
typedef unsigned short bf16_t;
typedef short bf16x8 __attribute__((ext_vector_type(8)));
typedef float f32x4 __attribute__((ext_vector_type(4)));
typedef unsigned u32x4 __attribute__((ext_vector_type(4)));
typedef unsigned u32x2 __attribute__((ext_vector_type(2)));
typedef _Float16 hf_t;
typedef _Float16 h16x4 __attribute__((ext_vector_type(4)));
typedef _Float16 h16x8 __attribute__((ext_vector_type(8)));

constexpr int D = 2048, NB = 4, SEQ = 4096, CTXL = 256, DEPTH = 2;
constexpr int RL = NB * SEQ;
constexpr int RC = NB * CTXL;
constexpr int R = RL + RC;
constexpr int SKV = CTXL + SEQ;
constexpr int DFF = 5632, MODW = 9 * D;
constexpr int INC = 2880, INCP = 3072;
constexpr int U_AQ = 0, U_AK = 1024, U_AV = 1280, U_BQ = 1536, U_BKV = 2048, U_BKR = 2304, U_CU = 2368;
constexpr float EPS = 1e-6f;
constexpr int LDP = D + 64;

constexpr size_t MiB = 1u << 20;
constexpr size_t al256(size_t x) { return (x + 255) / 256 * 256; }
constexpr size_t WS_CTL = 0, CTL_BYTES = 64 * 1024;
constexpr size_t WS_TAB = WS_CTL + CTL_BYTES;
constexpr size_t WS_MOD = WS_TAB + 64 * 1024;
constexpr int SWLD = 2 * DFF;
constexpr size_t WS_SW = al256(WS_MOD + (size_t)DEPTH * 5 * MODW * 4);
constexpr size_t WS_SSQ = WS_SW + (size_t)DEPTH * 3 * 5 * SWLD * 4;
constexpr size_t WS_RINV = WS_SSQ + (size_t)R * 32 * 4;
constexpr size_t WS_H = al256(WS_RINV + (size_t)R * 4);
constexpr size_t WS_XN = WS_H + (size_t)R * D * 4;
constexpr size_t WS_ACT = WS_XN + (size_t)R * LDP * 2;
constexpr size_t WS_U = WS_ACT;
constexpr size_t WS_QA = WS_U + (size_t)R * INCP * 4;
constexpr size_t WS_KA = WS_QA + (size_t)R * 1024 * 2;
constexpr size_t WS_VA = WS_KA + (size_t)NB * SKV * 256 * 2;
constexpr size_t WS_QB = WS_VA + (size_t)NB * SKV * 256 * 2;
constexpr size_t WS_KB = WS_QB + (size_t)R * 768 * 2;
constexpr size_t WS_VB = WS_KB + (size_t)NB * SKV * 768 * 2;
constexpr size_t WS_BQN = WS_VB + (size_t)NB * SKV * 512 * 2;
constexpr size_t WS_BKVN = WS_BQN + (size_t)R * 512 * 2;
constexpr size_t WS_POOL = WS_BKVN + (size_t)R * 256 * 2;
constexpr size_t WS_Y = WS_POOL + (size_t)R * 512 * 2;
constexpr size_t WS_W = WS_Y + (size_t)R * LDP * 2;
constexpr size_t W_F1IN = 0, W_F1OUT = W_F1IN + (size_t)2 * DFF * D * 2, W_IN = W_F1OUT + (size_t)D * DFF * 2, W_OUT = W_IN + (size_t)INCP * D * 2,
                 W_F2IN = W_OUT + (size_t)D * D * 2, W_F2OUT = W_F2IN + (size_t)2 * DFF * D * 2, W_UQ = W_F2OUT + (size_t)D * DFF * 2, W_UKV = W_UQ + (size_t)768 * 512 * 2,
                 W_PL = W_UKV + (size_t)1024 * 256 * 2, W_LAYER = W_PL + (size_t)512 * 512 * 2;
constexpr size_t WS_PART = WS_W + DEPTH * W_LAYER;
constexpr size_t WS_END = WS_PART + (size_t)8 * RC * D * 4;
static_assert(WS_ACT + (size_t)R * DFF * 2 <= WS_QA, "ACT fits in the U region");

constexpr int LDS_BYTES = 155648;
constexpr int BAR_OFF = LDS_BYTES - 16;

__device__ __forceinline__ unsigned cvt_pk_bf16(float lo, float hi) { unsigned r; asm volatile("v_cvt_pk_bf16_f32 %0, %1, %2" : "=v"(r) : "v"(lo), "v"(hi)); return r; }
__device__ __forceinline__ bf16_t f2bf(float x) { return (bf16_t)(cvt_pk_bf16(x, 0.f) & 0xffffu); }
__device__ __forceinline__ float bf2f(unsigned short x) { return __uint_as_float(((unsigned)x) << 16); }
__device__ __forceinline__ float wave_sum(float v, int lane) {
#pragma unroll
    for (int o = 1; o < 64; o <<= 1) v += __uint_as_float(__builtin_amdgcn_ds_bpermute((lane ^ o) << 2, __float_as_uint(v)));
    return v;
}
__device__ __forceinline__ float wave_max(float v, int lane) {
#pragma unroll
    for (int o = 1; o < 64; o <<= 1) v = fmaxf(v, __uint_as_float(__builtin_amdgcn_ds_bpermute((lane ^ o) << 2, __float_as_uint(v))));
    return v;
}
__device__ __forceinline__ int opaque(int x) { asm volatile("" : "+v"(x)); return x; }
__device__ __forceinline__ int tid_of(int wave_s) { int w = wave_s; asm volatile("" : "+s"(w)); int l; asm volatile("v_mbcnt_lo_u32_b32 %0, -1, 0\n\tv_mbcnt_hi_u32_b32 %0, -1, %0" : "=v"(l)); return w * 64 + l; }
__device__ __forceinline__ float xlane(float v, int src_lane) { return __uint_as_float(__builtin_amdgcn_ds_bpermute(src_lane << 2, __float_as_uint(v))); }
__device__ __forceinline__ u32x4 gather4(u32x4 v, int idx4) { u32x4 r; r.x = (unsigned)__builtin_amdgcn_ds_bpermute(idx4, (int)v.x); r.y = (unsigned)__builtin_amdgcn_ds_bpermute(idx4, (int)v.y);
    r.z = (unsigned)__builtin_amdgcn_ds_bpermute(idx4, (int)v.z); r.w = (unsigned)__builtin_amdgcn_ds_bpermute(idx4, (int)v.w); return r; }
__device__ __forceinline__ float silu(float a) { return a * __builtin_amdgcn_rcpf(1.f + __builtin_amdgcn_exp2f(a * -1.4426950408889634f)); }

#define XB_TMO      128
#define XB_XCNT(j)  (256  + 64 * (j))
#define XB_XSUB(j)  (1280 + 64 * (j))
#define XB_XGEN(j)  (2304 + 64 * (j))
#define XB_TOP      3328
#define XB_TOPGEN   3392
#define XCD_BAR_WORDS 3456
#define XB_SPIN_CAP (1u << 22)

__device__ __forceinline__ unsigned xb_ld(unsigned* p)              { return __hip_atomic_load(p, __ATOMIC_RELAXED, __HIP_MEMORY_SCOPE_AGENT); }
__device__ __forceinline__ unsigned xb_add(unsigned* p, unsigned v) { return __hip_atomic_fetch_add(p, v, __ATOMIC_RELAXED, __HIP_MEMORY_SCOPE_AGENT); }
__device__ __forceinline__ unsigned xb_xcc_id() { return (unsigned)__builtin_amdgcn_s_getreg((3 << 11) | 20) & 0xFu; }
#define XB_SPIN(cond, bar) do { unsigned _sp = 0; while (cond) { __builtin_amdgcn_s_sleep(1); \
    if ((++_sp & 255u) == 0u) { if (xb_ld(&(bar)[XB_TMO])) break; if (_sp > XB_SPIN_CAP) { atomicAdd(&(bar)[XB_TMO], 1u); break; } } } } while (0)

struct XcdBarrier { unsigned* bar; unsigned x; volatile LAS unsigned* st; };

__device__ __forceinline__ XcdBarrier xcd_barrier_post(unsigned* bar, volatile LAS unsigned* st) {
    XcdBarrier b; b.bar = bar; b.x = xb_xcc_id(); b.st = st;
    if (threadIdx.x == 0) (void)xb_add(&bar[XB_XCNT(b.x)], 1u);
    return b;
}
__device__ __forceinline__ void xcd_barrier_complete(unsigned* bar, unsigned x, unsigned& nloc, unsigned& nx) {
    const unsigned G = gridDim.x * gridDim.y * gridDim.z;
    unsigned sum, cnt, mine, sp = 0u;
    for (;;) {
        sum = 0u; cnt = 0u; mine = 0u;
#pragma unroll
        for (unsigned j = 0; j < 16; ++j) { const unsigned c = xb_ld(&bar[XB_XCNT(j)]); sum += c; cnt += (c > 0u) ? 1u : 0u; mine = (j == x) ? c : mine; }
        if (sum == G) break;
        __builtin_amdgcn_s_sleep(1);
        if ((++sp & 255u) == 0u) { if (xb_ld(&bar[XB_TMO])) break; if (sp > XB_SPIN_CAP) { atomicAdd(&bar[XB_TMO], 1u); break; } }
    }
    nloc = mine > 0u ? mine : 1u; nx = cnt > 0u ? cnt : 1u;
}
__device__ __forceinline__ void xcd_barrier(const XcdBarrier& b, const int wv) {
    asm volatile("s_waitcnt vmcnt(0)" ::: "memory");
    __syncthreads();
    if (tid_of(wv) == 0) {
        unsigned* bar = b.bar; asm volatile("" : "+s"(bar)); unsigned bx = __builtin_amdgcn_readfirstlane(b.x); asm volatile("" : "+s"(bx));
        __builtin_amdgcn_s_waitcnt(0);
        unsigned nloc = b.st[0], nx = b.st[1];
        if (nloc == 0u) { xcd_barrier_complete(bar, bx, nloc, nx); b.st[0] = nloc; b.st[1] = nx; }
        const unsigned old = xb_add(&bar[XB_XSUB(bx)], 1u);
        const unsigned gen = old / nloc;
        if (old + 1u == (gen + 1u) * nloc) {
            __builtin_amdgcn_fence(__ATOMIC_RELEASE, "agent");
            asm volatile("s_waitcnt vmcnt(0)" ::: "memory");
            const unsigned og = xb_add(&bar[XB_TOP], 1u);
            const unsigned tg = og / nx;
            if (og + 1u == (tg + 1u) * nx) xb_add(&bar[XB_TOPGEN], 1u);
            else XB_SPIN(xb_ld(&bar[XB_TOPGEN]) == tg, bar);
            __builtin_amdgcn_fence(__ATOMIC_ACQUIRE, "agent");
            xb_add(&bar[XB_XGEN(bx)], 1u);
            asm volatile("s_waitcnt vmcnt(0)" ::: "memory");
        } else {
            XB_SPIN(xb_ld(&bar[XB_XGEN(bx)]) == gen, bar);
            __builtin_amdgcn_fence(__ATOMIC_ACQUIRE, "agent");
            asm volatile("s_waitcnt vmcnt(0)" ::: "memory");
        }
    }
    __syncthreads();
}

namespace pg8 {
#define PG8_LAS __attribute__((address_space(3)))
constexpr int BM = 256, BK = 64, HALF = 128, HTB = HALF * BK * 2  , STAGE_BYTES = 8 * HTB, NXCD = 8, WGM = 8;

__host__ __device__ __forceinline__ int lds_byte(int r, int c) { const int st = (r >> 4) * 2 + (c >> 5), rr = r & 15, cc = c & 31, ob = rr * 64 + cc * 2; return st * 1024 + (ob ^ (((ob >> 9) & 1) << 5)); }
__host__ __device__ __forceinline__ void stage_rc(int b, int& R, int& C) { const int st = b / 1024, sb = b % 1024, swz = sb ^ (((sb >> 9) & 1) << 5); R = (st >> 1) * 16 + swz / 64; C = (st & 1) * 32 + (swz % 64) / 2; }
__host__ __device__ __forceinline__ int perm32(int rho) { const int n = rho >> 4, i = rho & 15; return 8 * (i >> 2) + 4 * n + (i & 3); }

struct Unit { int pm, pn, ko, nk, ks; };
struct Gemm { const bf16_t* A; const bf16_t* Bt; int M, N, K, ld, ldb; };
struct StaticOrder {
    int nM, nN, nwg, G, c, nk;
    __host__ __device__ void init(int M, int N, int G_, int c_, int K_) { nM = M / BM; nN = N / BM; nwg = nM * nN; G = G_; c = c_; nk = K_ / 64; }
    __host__ __device__ __forceinline__ bool next(int i, Unit& u) const {
        const long L = (long)i * G + c; if (L >= nwg) return false;
        int wgid = (int)L; { const int q = nwg / NXCD, r = nwg % NXCD, xcd = wgid % NXCD, off = wgid / NXCD; wgid = (xcd < r ? xcd * (q + 1) : r * (q + 1) + (xcd - r) * q) + off; }
        const int nig = WGM * nN, gid = wgid / nig, fm = gid * WGM, gsz = (nM - fm) < WGM ? (nM - fm) : WGM;
        u.pm = fm + ((wgid % nig) % gsz); u.pn = (wgid % nig) / gsz; u.ko = 0; u.nk = nk; return true;
    }
    __device__ __forceinline__ unsigned code(int i, unsigned& ko_) const { Unit u; u.pm = 0; u.pn = 0; u.ko = 0; u.nk = 0; u.ks = 0; const bool ok = next(i, u); ko_ = (unsigned)u.ko; return ok ? (0x80000000u | ((unsigned)u.nk << 16) | ((unsigned)u.pm << 8) | (unsigned)u.pn) : 0u; }
    __device__ __forceinline__ void a_ready(const Unit&) const {}
    __device__ __forceinline__ void done(const Unit&) const {}
};
struct MixOrder {
    StaticOrder lat; int nN, nks, nlat, nsp, t1, t2;
    __host__ __device__ void init(int N, int K, int nks_, int G_, int c_, bool with_ctx) { lat.init(64 * BM, N, G_, c_, K); nN = N / BM; nks = nks_; nlat = 64 * nN; nsp = with_ctx ? 4 * nN * nks : 0;
        const int pair = (K / 64) / (nks_ / 2); t1 = ((pair / 2 + 1) / 2) * 2; t2 = pair - t1; }
    __device__ __forceinline__ unsigned code(int i, unsigned& ko_) const {
        const int L = i * lat.G + lat.c; if (L < nlat) return lat.code(i, ko_);
        const int Lp = L - nlat; if (Lp >= nsp) { ko_ = 0u; return 0u; }
        const int r = Lp / nks, ks = Lp % nks; ko_ = (unsigned)(((ks >> 1) * (t1 + t2) + (ks & 1) * t1) * 64);
        return 0x80000000u | ((unsigned)ks << 24) | ((unsigned)((ks & 1) ? t2 : t1) << 16) | ((unsigned)(64 + (r & 3)) << 8) | (unsigned)(r >> 2);
    }
    __device__ __forceinline__ void a_ready(const Unit&) const {}
    __device__ __forceinline__ void done(const Unit&) const {}
};
template <class Epi, class Sched, bool ALIGN_EPI = false, bool SP2 = false>
__device__ __forceinline__ void gemm_phase(PG8_LAS unsigned char* lds, const Gemm g, const Sched& S, const Epi& E, const int wv) {
    int wid_ = wv; asm volatile("" : "+s"(wid_));
    const int tid = tid_of(wv), wid = wid_, lane = tid & 63, wr = wid >> 2, wc = wid & 3, fr = lane & 15, fq = lane >> 4;
    const int K = g.ld, Kb = g.ldb ? g.ldb : g.ld;
    unsigned voffA[2], voffB[2];
#pragma unroll
    for (int i = 0; i < 2; ++i) { int R, C; stage_rc(tid * 16 + i * 8192, R, C); const int Rb = Epi::PERM ? ((R & ~31) + perm32(R & 31)) : R;
        voffA[i] = (unsigned)(R * K + C) * 2u; voffB[i] = (unsigned)(Rb * Kb + C) * 2u; }
    const size_t kstep = (size_t)(BK * 2);
    const size_t hstepA = (size_t)HALF * K * 2, hstepB = (size_t)HALF * Kb * 2;
    const size_t tstepA = 2 * hstepA, tstepB = 2 * hstepB;
    const unsigned ldsw = (unsigned)wid * 1024u;
    const unsigned ldsb = (unsigned)(size_t)lds + ldsw;
    const int aoff = lds_byte(wr * 64 + fr, fq * 8), boff = lds_byte(wc * 32 + fr, fq * 8);
#define PG8_SA(b, h) (((b) * 2 + (h)) * HTB)
#define PG8_SB(b, h) ((4 + (b) * 2 + (h)) * HTB)
#define PG8_STAGE(bufoff, gbase, voff) do { _Pragma("unroll") for (int _i = 0; _i < 2; ++_i) \
        asm volatile("s_mov_b32 m0, %0\n\ts_nop 0\n\tglobal_load_lds_dwordx4 %1, %2" :: "s"(ldsb + (unsigned)((bufoff) + _i * 8192)), "v"((voff)[_i]), "s"(gbase) : "m0", "memory"); } while (0)
#define PG8_LDA(dst, b, h) do { _Pragma("unroll") for (int m = 0; m < 4; ++m) _Pragma("unroll") for (int k = 0; k < 2; ++k) dst[m][k] = *(const PG8_LAS bf16x8*)(lds + PG8_SA(b, h) + aoff + m * 2048 + k * 1024); } while (0)
#define PG8_LDB(dst, b, h) do { _Pragma("unroll") for (int n = 0; n < 2; ++n) _Pragma("unroll") for (int k = 0; k < 2; ++k) dst[n][k] = *(const PG8_LAS bf16x8*)(lds + PG8_SB(b, h) + boff + n * 2048 + k * 1024); } while (0)
#define PG8_MMA(ai, bj, At, Bt) do { __builtin_amdgcn_s_setprio(1); _Pragma("unroll") for (int m = 0; m < 4; ++m) _Pragma("unroll") for (int n = 0; n < 2; ++n) _Pragma("unroll") for (int k = 0; k < 2; ++k) \
        acc[ai][bj][m][n] = __builtin_amdgcn_mfma_f32_16x16x32_bf16(Bt[n][k], At[m][k], acc[ai][bj][m][n], 0, 0, 0); __builtin_amdgcn_s_setprio(0); } while (0)
#define PG8_WAIT_V(n) asm volatile("s_waitcnt vmcnt(" #n ")" ::: "memory")
#define PG8_WAIT_L(n) asm volatile("s_waitcnt lgkmcnt(" #n ")" ::: "memory")
#define PG8_BAR __builtin_amdgcn_s_barrier()
#define PG8_SCHED __builtin_amdgcn_sched_barrier(0)
    Unit cur, nxt; int ui = 0;
#define PG8_NEXT(i, u, ok) do { unsigned ko_; unsigned cd_ = S.code(i, ko_); cd_ = (unsigned)__builtin_amdgcn_readfirstlane((int)cd_); ko_ = (unsigned)__builtin_amdgcn_readfirstlane((int)ko_); \
        ok = (cd_ >> 31) != 0u; if (ok) { (u).pn = (int)(cd_ & 255u); (u).pm = (int)((cd_ >> 8) & 255u); (u).nk = (int)((cd_ >> 16) & 255u); (u).ks = (int)((cd_ >> 24) & 15u); (u).ko = (int)ko_; } } while (0)
    bool ok0_; cur.pm = 0; cur.pn = 0; cur.ko = 0; cur.nk = 4; cur.ks = 0; PG8_NEXT(0, cur, ok0_);
    if (!ok0_) return;
    f32x4 acc[2][2][4][2];
#pragma unroll
    for (int a = 0; a < 2; ++a)
#pragma unroll
        for (int b = 0; b < 2; ++b)
#pragma unroll
            for (int m = 0; m < 4; ++m)
#pragma unroll
                for (int n = 0; n < 2; ++n) acc[a][b][m][n] = (f32x4){0.f, 0.f, 0.f, 0.f};
    bf16x8 At[4][2], B0[2][2], B1[2][2];
    const char* cA = (const char*)g.A + (size_t)cur.pm * tstepA + (size_t)cur.ko * 2; const char* cB = (const char*)g.Bt + (size_t)cur.pn * tstepB + (size_t)cur.ko * 2;
    S.a_ready(cur);
    if constexpr (SP2) {
        PG8_STAGE(PG8_SB(0, 0), cB, voffB); PG8_STAGE(PG8_SB(0, 1), cB + hstepB, voffB); PG8_STAGE(PG8_SA(0, 0), cA, voffA); PG8_STAGE(PG8_SA(0, 1), cA + hstepA, voffA);
        if (wr == 1) PG8_BAR;
        PG8_WAIT_V(2); PG8_BAR;
        PG8_STAGE(PG8_SB(1, 0), cB + kstep, voffB); PG8_STAGE(PG8_SA(1, 0), cA + kstep, voffA); PG8_STAGE(PG8_SB(1, 1), cB + hstepB + kstep, voffB);
        PG8_WAIT_V(6); PG8_BAR;
    } else {
        PG8_STAGE(PG8_SB(0, 0), cB, voffB); PG8_STAGE(PG8_SA(0, 0), cA, voffA); PG8_STAGE(PG8_SB(0, 1), cB + hstepB, voffB); PG8_STAGE(PG8_SA(0, 1), cA + hstepA, voffA);
        if (wr == 1) PG8_BAR;
        PG8_WAIT_V(4); PG8_BAR;
        PG8_STAGE(PG8_SB(1, 0), cB + kstep, voffB); PG8_STAGE(PG8_SA(1, 0), cA + kstep, voffA); PG8_STAGE(PG8_SB(1, 1), cB + hstepB + kstep, voffB);
        PG8_WAIT_V(6); PG8_BAR;
    }
    for (;;) {
        nxt = cur; bool has_next; PG8_NEXT(ui + 1, nxt, has_next);
        const char* nA = has_next ? (const char*)g.A + (size_t)nxt.pm * tstepA + (size_t)nxt.ko * 2 : cA; const char* nB = has_next ? (const char*)g.Bt + (size_t)nxt.pn * tstepB + (size_t)nxt.ko * 2 : cB;
        const int nt = __builtin_amdgcn_readfirstlane(cur.nk);
        for (int t = 0; t < nt; t += 2) {
            const bool last = (t == nt - 2);
            const char* a1 = cA + (size_t)(t + 1) * kstep;
            const char* a2 = last ? nA : cA + (size_t)(t + 2) * kstep; const char* b2 = last ? nB : cB + (size_t)(t + 2) * kstep;
            const char* a3 = a2 + kstep; const char* b3 = b2 + kstep;
            if (last && has_next) S.a_ready(nxt);
            if constexpr (SP2) {
            PG8_LDB(B0, 0, 0); PG8_LDB(B1, 0, 1); PG8_SCHED; PG8_LDA(At, 0, 0); PG8_STAGE(PG8_SA(1, 1), a1 + hstepA, voffA);
            PG8_WAIT_V(8); PG8_WAIT_L(0); PG8_BAR; PG8_MMA(0, 0, At, B0); PG8_MMA(0, 1, At, B1); PG8_BAR; PG8_SCHED;
            PG8_LDA(At, 0, 1); PG8_STAGE(PG8_SB(0, 0), b2, voffB); PG8_STAGE(PG8_SB(0, 1), b2 + hstepB, voffB); PG8_STAGE(PG8_SA(0, 0), a2, voffA);
            PG8_WAIT_V(8); PG8_WAIT_L(0); PG8_BAR; PG8_MMA(1, 0, At, B0); PG8_MMA(1, 1, At, B1); PG8_BAR; PG8_SCHED;
            PG8_LDB(B0, 1, 0); PG8_LDB(B1, 1, 1); PG8_SCHED; PG8_LDA(At, 1, 0); PG8_STAGE(PG8_SA(0, 1), a2 + hstepA, voffA);
            PG8_WAIT_V(8); PG8_WAIT_L(0); PG8_BAR; PG8_MMA(0, 0, At, B0); PG8_MMA(0, 1, At, B1); PG8_BAR; PG8_SCHED;
            PG8_LDA(At, 1, 1); PG8_STAGE(PG8_SB(1, 0), b3, voffB); PG8_STAGE(PG8_SB(1, 1), b3 + hstepB, voffB); PG8_STAGE(PG8_SA(1, 0), a3, voffA);
            PG8_WAIT_V(8); PG8_WAIT_L(0); PG8_BAR; PG8_MMA(1, 0, At, B0); PG8_MMA(1, 1, At, B1); PG8_BAR; PG8_SCHED;
            } else {
            PG8_LDB(B0, 0, 0); PG8_SCHED; PG8_LDA(At, 0, 0); PG8_STAGE(PG8_SA(1, 1), a1 + hstepA, voffA);
            PG8_WAIT_L(8); PG8_BAR; PG8_WAIT_L(0); PG8_MMA(0, 0, At, B0); PG8_BAR; PG8_SCHED;
            PG8_LDB(B1, 0, 1); PG8_STAGE(PG8_SB(0, 0), b2, voffB);
            PG8_BAR; PG8_WAIT_L(0); PG8_MMA(0, 1, At, B1); PG8_BAR;
            PG8_LDA(At, 0, 1); PG8_STAGE(PG8_SA(0, 0), a2, voffA);
            PG8_BAR; PG8_WAIT_L(0); PG8_MMA(1, 0, At, B0); PG8_BAR; PG8_SCHED;
            PG8_STAGE(PG8_SB(0, 1), b2 + hstepB, voffB);
            PG8_WAIT_V(6); PG8_BAR; PG8_MMA(1, 1, At, B1); PG8_BAR;
            PG8_LDB(B0, 1, 0); PG8_SCHED; PG8_LDA(At, 1, 0); PG8_STAGE(PG8_SA(0, 1), a2 + hstepA, voffA);
            PG8_WAIT_L(8); PG8_BAR; PG8_WAIT_L(0); PG8_MMA(0, 0, At, B0); PG8_BAR; PG8_SCHED;
            PG8_LDB(B1, 1, 1); PG8_STAGE(PG8_SB(1, 0), b3, voffB);
            PG8_BAR; PG8_WAIT_L(0); PG8_MMA(0, 1, At, B1); PG8_BAR;
            PG8_LDA(At, 1, 1); PG8_STAGE(PG8_SA(1, 0), a3, voffA);
            PG8_BAR; PG8_WAIT_L(0); PG8_MMA(1, 0, At, B0); PG8_BAR; PG8_SCHED;
            PG8_STAGE(PG8_SB(1, 1), b3 + hstepB, voffB);
            PG8_WAIT_V(6); PG8_BAR; PG8_MMA(1, 1, At, B1); PG8_BAR;
            }
        }
        if constexpr (ALIGN_EPI) { if (wr == 0) PG8_BAR; }
        if constexpr (!Epi::AFTER_DRAIN) { E(acc, cur, wr, wc, fr, fq); S.done(cur); }
        if (!has_next) break;
#pragma unroll
        for (int a = 0; a < 2; ++a)
#pragma unroll
            for (int b = 0; b < 2; ++b)
#pragma unroll
                for (int m = 0; m < 4; ++m)
#pragma unroll
                    for (int n = 0; n < 2; ++n) acc[a][b][m][n] = (f32x4){0.f, 0.f, 0.f, 0.f};
        cur = nxt; cA = nA; cB = nB; ++ui;
        if constexpr (ALIGN_EPI) { if (wr == 1) PG8_BAR; }
    }
    PG8_WAIT_V(0);
    if constexpr (!ALIGN_EPI) { if (wr == 0) PG8_BAR; }
    PG8_BAR;
    if constexpr (Epi::AFTER_DRAIN) { E.fused(acc, cur, wr, wc, fr, fq, lds, wid, lane); S.done(cur); }
#undef PG8_SA
#undef PG8_SB
#undef PG8_STAGE
#undef PG8_LDA
#undef PG8_LDB
#undef PG8_MMA
#undef PG8_WAIT_V
#undef PG8_WAIT_L
#undef PG8_BAR
#undef PG8_SCHED
}
}

typedef const f32x4 (&AccT)[2][2][4][2];
__device__ __forceinline__ void load_rinv(const float* RINV, int row0, float (&rinv)[2][4]) {
#pragma unroll
    for (int ai = 0; ai < 2; ++ai)
#pragma unroll
        for (int m = 0; m < 4; ++m) rinv[ai][m] = RINV[row0 + ai * 128 + m * 16];
}
struct EpiSwiglu {
    static constexpr bool PERM = true, AFTER_DRAIN = false;
    bf16_t* O; const float* RINV; const float* sw;
    __device__ __forceinline__ void operator()(AccT acc, const pg8::Unit& u, int wr, int wc, int fr, int fq) const {
        const int row0 = u.pm * 256 + wr * 64 + fr, bidx = u.pm < 64 ? (u.pm >> 4) : 4, l_ = fq * 16 + fr, st4 = ((l_ & 3) * 16 + (l_ >> 2)) * 4;
        bf16_t* obase = O + (size_t)(u.pm * 256 + wr * 64 + (l_ >> 2)) * DFF + u.pn * 128 + wc * 32 + (l_ & 3) * 8;
        float rinv[2][4]; load_rinv(RINV, row0, rinv);
        const float* swp = sw + (size_t)bidx * SWLD + u.pn * 256 + wc * 32 + 8 * fq;
        const f32x4 sa0 = *(const f32x4*)swp, sa1 = *(const f32x4*)(swp + 4), sb0 = *(const f32x4*)(swp + 128), sb1 = *(const f32x4*)(swp + 132);
#pragma unroll
        for (int ai = 0; ai < 2; ++ai)
#pragma unroll
            for (int m = 0; m < 4; ++m) { const float r = rinv[ai][m];
                const f32x4 a0 = acc[ai][0][m][0] * r + sa0, a1 = acc[ai][0][m][1] * r + sa1, b0 = acc[ai][1][m][0] * r + sb0, b1 = acc[ai][1][m][1] * r + sb1;
                u32x4 w;
                w.x = cvt_pk_bf16(silu(a0[0]) * b0[0], silu(a0[1]) * b0[1]); w.y = cvt_pk_bf16(silu(a0[2]) * b0[2], silu(a0[3]) * b0[3]);
                w.z = cvt_pk_bf16(silu(a1[0]) * b1[0], silu(a1[1]) * b1[1]); w.w = cvt_pk_bf16(silu(a1[2]) * b1[2], silu(a1[3]) * b1[3]);
                *(u32x4*)(obase + (size_t)(ai * 128 + m * 16) * DFF) = gather4(w, st4);
            }
    }
};
template <bool WZ, bool B32> struct EpiResid {
    static constexpr bool PERM = true, AFTER_DRAIN = false;
    hf_t* H; const void* baseL; const void* baseC;
    const float* gate;
    bf16_t* Z; const float* gnext; const float* scnext; float* SSQ; float coef, pad_;
    __device__ __forceinline__ void operator()(AccT acc, const pg8::Unit& u, int wr, int wc, int fr, int fq) const {
        const int row0 = u.pm * 256 + wr * 64 + fr, col0 = u.pn * 256 + wc * 32 + 8 * fq, lane = fq * 16 + fr;
        const int bidx = u.pm < 64 ? (u.pm >> 4) : 4;
        const float* gp = gate + (size_t)bidx * MODW + col0;
        f32x4 gv[2][2], gz[2][2];
#pragma unroll
        for (int bj = 0; bj < 2; ++bj)
#pragma unroll
            for (int n = 0; n < 2; ++n) { gv[bj][n] = *(const f32x4*)(gp + bj * 128 + n * 4) * coef;
                if (WZ) gz[bj][n] = *(const f32x4*)(gnext + col0 + bj * 128 + n * 4) * (*(const f32x4*)(scnext + (size_t)bidx * MODW + col0 + bj * 128 + n * 4) + 1.f); }
        const int st4 = ((lane & 3) * 16 + (lane >> 2)) * 4, ld4 = ((lane & 15) * 4 + (lane >> 4)) * 4;
        const size_t eo = (size_t)(u.pm * 256 + wr * 64 + (lane >> 2)) * LDP + u.pn * 256 + wc * 32 + (lane & 3) * 8;
        hf_t* hout = H + eo; bf16_t* zout = Z + eo; float ss[8];
        if constexpr (B32) {
            const float* base = (const float*)(u.pm < 64 ? baseL : baseC) + (size_t)row0 * D + col0;
            f32x4 hb[4][2][2];
#pragma unroll
            for (int ai = 0; ai < 2; ++ai) {
#pragma unroll
                for (int m = 0; m < 4; ++m)
#pragma unroll
                    for (int bj = 0; bj < 2; ++bj)
#pragma unroll
                        for (int n = 0; n < 2; ++n) hb[m][bj][n] = __builtin_nontemporal_load((const f32x4*)(base + (size_t)(ai * 128 + m * 16) * D + bj * 128 + n * 4));
                asm volatile("" ::: "memory");
#pragma unroll
                for (int m = 0; m < 4; ++m) { const size_t ro = (size_t)(ai * 128 + m * 16) * LDP; float t = 0.f;
#pragma unroll
                    for (int bj = 0; bj < 2; ++bj) { const f32x4 h0 = hb[m][bj][0] + gv[bj][0] * acc[ai][bj][m][0], h1 = hb[m][bj][1] + gv[bj][1] * acc[ai][bj][m][1];
                        const h16x4 q0 = __builtin_convertvector(h0, h16x4), q1 = __builtin_convertvector(h1, h16x4);
                        { const h16x8 hv8 = (h16x8){q0[0], q0[1], q0[2], q0[3], q1[0], q1[1], q1[2], q1[3]}; *(u32x4*)(hout + ro + bj * 128) = gather4(__builtin_bit_cast(u32x4, hv8), st4); }
                        t += ((h0[0] * h0[0] + h0[1] * h0[1]) + (h0[2] * h0[2] + h0[3] * h0[3])) + ((h1[0] * h1[0] + h1[1] * h1[1]) + (h1[2] * h1[2] + h1[3] * h1[3]));
                        if (WZ) { const f32x4 z0 = h0 * gz[bj][0], z1 = h1 * gz[bj][1]; u32x4 w; w.x = cvt_pk_bf16(z0[0], z0[1]); w.y = cvt_pk_bf16(z0[2], z0[3]); w.z = cvt_pk_bf16(z1[0], z1[1]); w.w = cvt_pk_bf16(z1[2], z1[3]);
                            *(u32x4*)(zout + ro + bj * 128) = gather4(w, st4); } }
                    ss[ai * 4 + m] = t; }
                asm volatile("" ::: "memory");
            }
        } else {
            const hf_t* base = (const hf_t*)(u.pm < 64 ? baseL : baseC) + eo;
            h16x8 hb[4][2];
#pragma unroll
            for (int ai = 0; ai < 2; ++ai) {
#pragma unroll
                for (int m = 0; m < 4; ++m)
#pragma unroll
                    for (int bj = 0; bj < 2; ++bj) hb[m][bj] = *(const h16x8*)(base + (size_t)(ai * 128 + m * 16) * LDP + bj * 128);
                asm volatile("" ::: "memory");
#pragma unroll
                for (int m = 0; m < 4; ++m) { const size_t ro = (size_t)(ai * 128 + m * 16) * LDP; float t = 0.f;
#pragma unroll
                    for (int bj = 0; bj < 2; ++bj) { const h16x8 b8 = __builtin_bit_cast(h16x8, gather4(__builtin_bit_cast(u32x4, hb[m][bj]), ld4));
                        const f32x4 h0 = (f32x4){(float)b8[0], (float)b8[1], (float)b8[2], (float)b8[3]} + gv[bj][0] * acc[ai][bj][m][0], h1 = (f32x4){(float)b8[4], (float)b8[5], (float)b8[6], (float)b8[7]} + gv[bj][1] * acc[ai][bj][m][1];
                        const h16x4 q0 = __builtin_convertvector(h0, h16x4), q1 = __builtin_convertvector(h1, h16x4);
                        { const h16x8 hv8 = (h16x8){q0[0], q0[1], q0[2], q0[3], q1[0], q1[1], q1[2], q1[3]}; *(u32x4*)(hout + ro + bj * 128) = gather4(__builtin_bit_cast(u32x4, hv8), st4); }
                        t += ((h0[0] * h0[0] + h0[1] * h0[1]) + (h0[2] * h0[2] + h0[3] * h0[3])) + ((h1[0] * h1[0] + h1[1] * h1[1]) + (h1[2] * h1[2] + h1[3] * h1[3]));
                        if (WZ) { const f32x4 z0 = h0 * gz[bj][0], z1 = h1 * gz[bj][1]; u32x4 w; w.x = cvt_pk_bf16(z0[0], z0[1]); w.y = cvt_pk_bf16(z0[2], z0[3]); w.z = cvt_pk_bf16(z1[0], z1[1]); w.w = cvt_pk_bf16(z1[2], z1[3]);
                            *(u32x4*)(zout + ro + bj * 128) = gather4(w, st4); } }
                    ss[ai * 4 + m] = t; }
                asm volatile("" ::: "memory");
            }
        }
#pragma unroll
        for (int g = 0; g < 8; ++g) { float t = ss[g]; t += xlane(t, lane ^ 16); t += xlane(t, lane ^ 32);
            if (fq == 0) SSQ[(size_t)(row0 + (g >> 2) * 128 + (g & 3) * 16) * 32 + u.pn * 4 + wc] = t; }
    }
};
struct EpiU {
    static constexpr bool PERM = true, AFTER_DRAIN = false;
    bf16_t* U; const float* RINV; const float* sw;
    __device__ __forceinline__ void operator()(AccT acc, const pg8::Unit& u, int wr, int wc, int fr, int fq) const {
        const int row0 = u.pm * 256 + wr * 64 + fr, col0 = u.pn * 256 + wc * 32 + 8 * fq, bidx = u.pm < 64 ? (u.pm >> 4) : 4, l_ = fq * 16 + fr, st4 = ((l_ & 3) * 16 + (l_ >> 2)) * 4;
        bf16_t* obase = U + (size_t)(u.pm * 256 + wr * 64 + (l_ >> 2)) * INCP + u.pn * 256 + wc * 32 + (l_ & 3) * 8;
        float rinv[2][4]; load_rinv(RINV, row0, rinv);
        const float* swp = sw + (size_t)bidx * SWLD + col0;
        f32x4 sv[2][2];
#pragma unroll
        for (int bj = 0; bj < 2; ++bj) { sv[bj][0] = *(const f32x4*)(swp + bj * 128); sv[bj][1] = *(const f32x4*)(swp + bj * 128 + 4); }
#pragma unroll
        for (int ai = 0; ai < 2; ++ai)
#pragma unroll
            for (int m = 0; m < 4; ++m) { const float r = rinv[ai][m]; bf16_t* rowp = obase + (size_t)(ai * 128 + m * 16) * INCP;
#pragma unroll
                for (int bj = 0; bj < 2; ++bj) { const f32x4 v0 = acc[ai][bj][m][0] * r + sv[bj][0], v1 = acc[ai][bj][m][1] * r + sv[bj][1];
                    u32x4 w; w.x = cvt_pk_bf16(v0[0], v0[1]); w.y = cvt_pk_bf16(v0[2], v0[3]); w.z = cvt_pk_bf16(v1[0], v1[1]); w.w = cvt_pk_bf16(v1[2], v1[3]);
                    *(u32x4*)(rowp + bj * 128) = gather4(w, st4); } }
    }
};
struct EpiPartial {
    static constexpr bool PERM = true, AFTER_DRAIN = false;
    hf_t* P; int N;
    __device__ __forceinline__ void operator()(AccT acc, const pg8::Unit& u, int wr, int wc, int fr, int fq) const {
        const int ks = u.ks, l_ = fq * 16 + fr, st4 = ((l_ & 3) * 16 + (l_ >> 2)) * 4;
        hf_t* base = P + ((size_t)ks * RC + (u.pm - 64) * 256 + wr * 64 + (l_ >> 2)) * N + u.pn * 256 + wc * 32 + (l_ & 3) * 8;
#pragma unroll
        for (int ai = 0; ai < 2; ++ai)
#pragma unroll
            for (int m = 0; m < 4; ++m) { hf_t* rowp = base + (size_t)(ai * 128 + m * 16) * N;
#pragma unroll
                for (int bj = 0; bj < 2; ++bj) { const h16x4 q0 = __builtin_convertvector(acc[ai][bj][m][0], h16x4), q1 = __builtin_convertvector(acc[ai][bj][m][1], h16x4);
                    const h16x8 hv8 = (h16x8){q0[0], q0[1], q0[2], q0[3], q1[0], q1[1], q1[2], q1[3]}; *(u32x4*)(rowp + bj * 128) = gather4(__builtin_bit_cast(u32x4, hv8), st4); } }
    }
};
template <class EA> struct EpiMix {
    static constexpr bool PERM = true, AFTER_DRAIN = false, PF = false;
    EA a; EpiPartial b;
    __device__ __forceinline__ void operator()(AccT acc, const pg8::Unit& u, int wr, int wc, int fr, int fq) const { if (u.pm < 64) a(acc, u, wr, wc, fr, fq); else b(acc, u, wr, wc, fr, fq); }
};
struct EpiUq {
    static constexpr bool PERM = true, AFTER_DRAIN = false;
    bf16_t* QB; const float* cosB; const float* sinB;
    __device__ __forceinline__ void operator()(AccT acc, const pg8::Unit& u, int wr, int wc, int fr, int fq) const {
        const int row0 = u.pm * 256 + wr * 64 + fr, l_ = fq * 16 + fr, st4 = ((l_ & 3) * 16 + (l_ >> 2)) * 4;
        bf16_t* obase = QB + (size_t)(u.pm * 256 + wr * 64 + (l_ >> 2)) * 768 + u.pn * 256 + wc * 32 + (l_ & 3) * 8;
        const bool lat = u.pm < 64;
#pragma unroll
        for (int bj = 0; bj < 2; ++bj) {
            const int col0 = u.pn * 256 + bj * 128 + wc * 32 + 8 * fq;
            const int within = col0 % 192; const bool rope = lat && within >= 128; const int j0 = (within - 128) >> 1;
#pragma unroll
            for (int ai = 0; ai < 2; ++ai)
#pragma unroll
                for (int m = 0; m < 4; ++m) {
                    const int row = row0 + ai * 128 + m * 16;
                    f32x4 v0 = acc[ai][bj][m][0], v1 = acc[ai][bj][m][1];
                    if (rope) {
                        const int t = row & 4095, pr = t >> 6, pc = t & 63;
                        float x[8] = {v0[0], v0[1], v0[2], v0[3], v1[0], v1[1], v1[2], v1[3]};
#pragma unroll
                        for (int q = 0; q < 4; ++q) { const int j = j0 + q; const int idx = j < 16 ? pr * 16 + j : pc * 16 + (j - 16); const float c = cosB[idx], s = sinB[idx];
                            const float a = x[2 * q], b = x[2 * q + 1]; x[2 * q] = a * c - b * s; x[2 * q + 1] = a * s + b * c; }
                        v0 = (f32x4){x[0], x[1], x[2], x[3]}; v1 = (f32x4){x[4], x[5], x[6], x[7]};
                    }
                    u32x4 w; w.x = cvt_pk_bf16(v0[0], v0[1]); w.y = cvt_pk_bf16(v0[2], v0[3]); w.z = cvt_pk_bf16(v1[0], v1[1]); w.w = cvt_pk_bf16(v1[2], v1[3]);
                    *(u32x4*)(obase + (size_t)(ai * 128 + m * 16) * 768 + bj * 128) = gather4(w, st4);
                }
        }
    }
};
struct EpiUkv {
    static constexpr bool PERM = true, AFTER_DRAIN = false;
    bf16_t* KB; bf16_t* VB;
    __device__ __forceinline__ void operator()(AccT acc, const pg8::Unit& u, int wr, int wc, int fr, int fq) const {
        const int l_ = fq * 16 + fr, st4 = ((l_ & 3) * 16 + (l_ >> 2)) * 4, row0 = u.pm * 256 + wr * 64 + (l_ >> 2), c0 = wc * 32 + (l_ & 3) * 8;
#pragma unroll
        for (int ai = 0; ai < 2; ++ai)
#pragma unroll
            for (int m = 0; m < 4; ++m) {
                const int row = row0 + ai * 128 + m * 16;
                size_t kvrow; if (row < RL) kvrow = (size_t)(row >> 12) * SKV + CTXL + (row & 4095); else { const int rc = row - RL; kvrow = (size_t)(rc >> 8) * SKV + (rc & 255); }
#pragma unroll
                for (int bj = 0; bj < 2; ++bj) { const f32x4 v0 = acc[ai][bj][m][0], v1 = acc[ai][bj][m][1];
                    u32x4 w; w.x = cvt_pk_bf16(v0[0], v0[1]); w.y = cvt_pk_bf16(v0[2], v0[3]); w.z = cvt_pk_bf16(v1[0], v1[1]); w.w = cvt_pk_bf16(v1[2], v1[3]);
                    w = gather4(w, st4);
                    if (bj == 0) *(u32x4*)(KB + kvrow * 768 + u.pn * 192 + c0) = w; else *(u32x4*)(VB + kvrow * 512 + u.pn * 128 + c0) = w; }
            }
    }
};
struct EpiPool {
    static constexpr bool PERM = true, AFTER_DRAIN = false;
    bf16_t* Y;
    __device__ __forceinline__ void operator()(AccT acc, const pg8::Unit& u, int wr, int wc, int fr, int fq) const {
        const int l_ = fq * 16 + fr, st4 = ((l_ & 3) * 16 + (l_ >> 2)) * 4, row0 = u.pm * 256 + wr * 64 + (l_ >> 2), col0 = 1536 + u.pn * 256 + wc * 32 + (l_ & 3) * 8;
#pragma unroll
        for (int ai = 0; ai < 2; ++ai)
#pragma unroll
            for (int m = 0; m < 4; ++m)
#pragma unroll
                for (int bj = 0; bj < 2; ++bj) { const f32x4 v0 = acc[ai][bj][m][0], v1 = acc[ai][bj][m][1];
                    u32x4 w; w.x = cvt_pk_bf16(v0[0], v0[1]); w.y = cvt_pk_bf16(v0[2], v0[3]); w.z = cvt_pk_bf16(v1[0], v1[1]); w.w = cvt_pk_bf16(v1[2], v1[3]);
                    *(u32x4*)(Y + (size_t)(row0 + ai * 128 + m * 16) * LDP + col0 + bj * 128) = gather4(w, st4); }
    }
};

struct Params { const float* in[22]; float* out; unsigned char* ws; };
enum { I_X = 0, I_C, I_CTX, I_CCTX, I_WMOD, I_BMOD, I_NORMG, I_F1IN, I_F1OUT, I_WIN, I_AQG, I_AKG, I_BQG, I_BKVG, I_WUQ, I_WUKV, I_WPOOL, I_CSCALE, I_WOUT, I_F2IN, I_F2OUT, I_FINALG };

__device__ __forceinline__ void p0_tables(float* tab, const int wv) {
    for (int i = tid_of(wv); i < 64 * 32 + 64 * 16; i += 512) {
        if (i < 64 * 32) { const int p = i >> 5, f = i & 31; const float inv = powf(10000.f, -(float)f / 32.f), ang = (float)p * inv; tab[i] = cosf(ang); tab[2048 + i] = sinf(ang); }
        else { const int k = i - 2048, p = k >> 4, f = k & 15; const float inv = powf(10000.f, -(float)f / 16.f), ang = (float)p * inv; tab[4096 + k] = cosf(ang); tab[4096 + 1024 + k] = sinf(ang); }
    }
}
__device__ __forceinline__ void p0_mod(const Params& p, float* MOD, float* lds_f, const int wv) {
    float* act = lds_f; float* red = lds_f + 5 * D;
    const int tid = tid_of(wv);
    for (int i = tid; i < 5 * D; i += 512) { const int r = i >> 11, k = i & 2047; const float v = r < 4 ? p.in[I_C][r * D + k] : p.in[I_CCTX][k]; act[i] = silu(v); }
    __syncthreads();
    const int cg = tid & 31, ks = tid >> 5;
    for (int item = blockIdx.x; item < 2 * 144; item += gridDim.x) {
        const int layer = item / 144, n0 = (item % 144) * 128;
        const float* W = p.in[I_WMOD] + (size_t)layer * D * MODW + n0 + cg * 4;
        f32x4 acc[5];
#pragma unroll
        for (int r = 0; r < 5; ++r) acc[r] = (f32x4){0.f, 0.f, 0.f, 0.f};
        for (int k = ks * 128; k < ks * 128 + 128; k += 8) {
            f32x4 w[8];
#pragma unroll
            for (int j = 0; j < 8; ++j) w[j] = __builtin_nontemporal_load((const f32x4*)(W + (size_t)(k + j) * MODW));
#pragma unroll
            for (int j = 0; j < 8; ++j)
#pragma unroll
                for (int r = 0; r < 5; ++r) acc[r] = acc[r] + w[j] * act[r * D + k + j];
        }
#pragma unroll
        for (int r = 0; r < 5; ++r) *(f32x4*)(red + (ks * 32 + cg) * 20 + r * 4) = acc[r];
        __syncthreads();
        for (int o = tid; o < 640; o += 512) { const int r = o >> 7, col = o & 127, cg2 = col >> 2, e = col & 3; float s = 0.f;
#pragma unroll
            for (int q = 0; q < 16; ++q) s += red[(q * 32 + cg2) * 20 + r * 4 + e];
            MOD[(size_t)(layer * 5 + r) * MODW + n0 + col] = s + p.in[I_BMOD][layer * MODW + n0 + col]; }
        __syncthreads();
    }
}
__device__ __forceinline__ void cvt_matrix(const float* __restrict__ src, int K, int N, bf16_t* __restrict__ dst, int kind, int& base, float* lds_f, const int wv) {
    const int tid = tid_of(wv), G = gridDim.x, nkt = K / 256, nnb = N / 64, ntiles = nkt * nnb;
    const int b_ = blockIdx.x, PER = 3 * G + (G - 32);
    for (int q_ = base / PER; q_ * PER < base + ntiles; ++q_)
    for (int sl_ = 0; sl_ < 4; ++sl_) {
        if (sl_ == 3 && b_ < 32) continue;
        const int g_ = q_ * PER + (sl_ < 3 ? b_ + G * sl_ : 3 * G + b_ - 32), t = g_ - base;
        if (t < 0 || t >= ntiles) continue;
        const int kt = t / nnb, nb = t % nnb, k0 = kt * 256, n0 = nb * 64;
        int drow0 = n0, perm = 0;
        if (kind == 1) { if (n0 < DFF) drow0 = 256 * (n0 >> 7) + (n0 & 127); else { const int n1 = n0 - DFF; drow0 = 256 * (n1 >> 7) + 128 + (n1 & 127); } }
        if (kind == 2) perm = (n0 % 192) == 128;
        { const int c4 = tid & 15, kr = tid >> 4;
          f32x4 v[8];
#pragma unroll
          for (int i = 0; i < 8; ++i) v[i] = __builtin_nontemporal_load((const f32x4*)(src + (size_t)(k0 + kr + 32 * i) * N + n0 + 4 * c4));
#pragma unroll
          for (int i = 0; i < 8; ++i) { float* l = lds_f + (kr + 32 * i) * 65 + 4 * c4; l[0] = v[i][0]; l[1] = v[i][1]; l[2] = v[i][2]; l[3] = v[i][3]; } }
        __syncthreads();
#pragma unroll
        for (int j = 0; j < 4; ++j) { const int idx = tid + 512 * j, r = ((idx >> 6) & 3) * 16 + ((idx >> 2) & 15), kc = (idx >> 8) * 4 + (idx & 3);
            const int sc = perm ? ((r & 1) ? 32 + (r >> 1) : (r >> 1)) : r;
            const float* l = lds_f + (kc * 8) * 65 + sc;
            u32x4 w; w.x = cvt_pk_bf16(l[0], l[65]); w.y = cvt_pk_bf16(l[2 * 65], l[3 * 65]); w.z = cvt_pk_bf16(l[4 * 65], l[5 * 65]); w.w = cvt_pk_bf16(l[6 * 65], l[7 * 65]);
            *(u32x4*)(dst + (size_t)(drow0 + r) * K + k0 + kc * 8) = w; }
        __syncthreads();
    }
    base += ntiles;
}
__device__ __forceinline__ void p0_weights(const Params& p, float* lds_f, const int wv) {
    int base = 0;
    const size_t gt = (size_t)blockIdx.x * 512 + tid_of(wv), gs = (size_t)gridDim.x * 512;
    for (int l = 0; l < DEPTH; ++l) {
        unsigned char* wl = p.ws + WS_W + (size_t)l * W_LAYER;
        cvt_matrix(p.in[I_F1IN] + (size_t)l * D * 2 * DFF, D, 2 * DFF, (bf16_t*)(wl + W_F1IN), 1, base, lds_f, wv);
        cvt_matrix(p.in[I_F2IN] + (size_t)l * D * 2 * DFF, D, 2 * DFF, (bf16_t*)(wl + W_F2IN), 1, base, lds_f, wv);
        cvt_matrix(p.in[I_F1OUT] + (size_t)l * DFF * D, DFF, D, (bf16_t*)(wl + W_F1OUT), 0, base, lds_f, wv);
        cvt_matrix(p.in[I_F2OUT] + (size_t)l * DFF * D, DFF, D, (bf16_t*)(wl + W_F2OUT), 0, base, lds_f, wv);
        cvt_matrix(p.in[I_WIN] + (size_t)l * D * INC, D, INC, (bf16_t*)(wl + W_IN), 0, base, lds_f, wv);
        cvt_matrix(p.in[I_WOUT] + (size_t)l * D * D, D, D, (bf16_t*)(wl + W_OUT), 0, base, lds_f, wv);
        cvt_matrix(p.in[I_WUQ] + (size_t)l * 512 * 768, 512, 768, (bf16_t*)(wl + W_UQ), 2, base, lds_f, wv);
        cvt_matrix(p.in[I_WUKV] + (size_t)l * 256 * 1024, 256, 1024, (bf16_t*)(wl + W_UKV), 0, base, lds_f, wv);
        { u32x4* z = (u32x4*)((bf16_t*)(wl + W_IN) + (size_t)INC * D); const size_t nz = (size_t)(INCP - INC) * D / 8; for (size_t i = gt; i < nz; i += gs) z[i] = (u32x4){0u, 0u, 0u, 0u}; }
        { bf16_t* wp = (bf16_t*)(wl + W_PL); const float* src = p.in[I_WPOOL] + (size_t)l * 4 * 128 * 128; const float* sc = p.in[I_CSCALE] + l * 512;
          for (size_t i = gt; i < 512 * 512; i += gs) { const int n = (int)(i >> 9), k = (int)(i & 511), g = n >> 7, d = n & 127, g2 = k >> 7, c = k & 127;
              wp[i] = (g == g2) ? f2bf(src[(g * 128 + c) * 128 + d] * sc[n]) : (bf16_t)0; } }
    }
}
__device__ __forceinline__ void p0b_z0(const Params& p, const float* MOD, bf16_t* Z, float* SSQ, float* RINV, const int wv) {
    const int tidx = tid_of(wv), lane = tidx & 63, gw = blockIdx.x * 8 + (tidx >> 6), NGW = gridDim.x * 8;
    const f32x4* gp = (const f32x4*)p.in[I_NORMG] + lane;
    f32x4 cur[8];
    if (gw < R) { const f32x4* hp = (const f32x4*)(gw < RL ? p.in[I_X] + (size_t)gw * D : p.in[I_CTX] + (size_t)(gw - RL) * D) + lane;
#pragma unroll
        for (int j = 0; j < 8; ++j) cur[j] = __builtin_nontemporal_load(hp + 64 * j); }
    for (int row = gw; row < R; row += NGW) {
        const int bidx = row < RL ? (row >> 12) : 4, nrow = row + NGW;
        f32x4 nxt[8];
#pragma unroll
        for (int j = 0; j < 8; ++j) nxt[j] = cur[j];
        if (nrow < R) { const f32x4* hp = (const f32x4*)(nrow < RL ? p.in[I_X] + (size_t)nrow * D : p.in[I_CTX] + (size_t)(nrow - RL) * D) + lane;
#pragma unroll
            for (int j = 0; j < 8; ++j) nxt[j] = __builtin_nontemporal_load(hp + 64 * j); }
        const f32x4* sp = (const f32x4*)(MOD + (size_t)bidx * MODW + D) + lane;
        f32x4 gs[8];
#pragma unroll
        for (int j = 0; j < 8; ++j) gs[j] = gp[64 * j] * (sp[64 * j] + 1.f);
        asm volatile("" ::: "memory");
        float ss = 0.f;
#pragma unroll
        for (int j = 0; j < 8; ++j) ss += (cur[j][0] * cur[j][0] + cur[j][1] * cur[j][1]) + (cur[j][2] * cur[j][2] + cur[j][3] * cur[j][3]);
        ss = wave_sum(ss, lane);
        u32x2* op = (u32x2*)(Z + (size_t)row * LDP) + lane;
#pragma unroll
        for (int j = 0; j < 8; ++j) { const f32x4 o = cur[j] * gs[j]; u32x2 w; w.x = cvt_pk_bf16(o[0], o[1]); w.y = cvt_pk_bf16(o[2], o[3]); op[64 * j] = w; }
        if (lane < 32) SSQ[(size_t)row * 32 + lane] = lane == 0 ? ss : 0.f;
        if (lane == 0) RINV[row] = rsqrtf(ss * (1.f / D) + EPS);
#pragma unroll
        for (int j = 0; j < 8; ++j) cur[j] = nxt[j];
    }
}
typedef __bf16 bf16v2 __attribute__((ext_vector_type(2)));
#define DOT2(a, b, c) __builtin_amdgcn_fdot2_f32_bf16(__builtin_bit_cast(bf16v2, (unsigned)(a)), __builtin_bit_cast(bf16v2, (unsigned)(b)), (c), false)
#define DPP_ADD(v, CTRL) (v) += __uint_as_float(__builtin_amdgcn_update_dpp(0u, __float_as_uint(v), CTRL, 0xf, 0xf, true))
__device__ __forceinline__ void p0b_sw(const unsigned char* ws, const float* MOD, float* SW, float* lds_f, const int wv) {
    const int tidx = tid_of(wv), lane = tidx & 63, gw = blockIdx.x * 8 + (tidx >> 6), NGW = gridDim.x * 8, sub = lane & 15;
    bf16_t* sh16 = (bf16_t*)lds_f;
    __syncthreads();
    for (int i = tidx; i < DEPTH * 3 * 5 * D / 4; i += 512) { const int cb = i / (D / 4), k4 = i % (D / 4), c = cb / 5, b = cb % 5, l = c / 3, sidx = c % 3;
        const f32x4 v = *(const f32x4*)(MOD + (size_t)(l * 5 + b) * MODW + sidx * 3 * D + k4 * 4);
        u32x2 w; w.x = cvt_pk_bf16(v[0], v[1]); w.y = cvt_pk_bf16(v[2], v[3]); *(u32x2*)(sh16 + (size_t)cb * D + k4 * 4) = w; }
    __syncthreads();
    constexpr int G0 = 2 * DFF / 4, G1 = INCP / 4, GL = 2 * G0 + G1;
#pragma unroll 1
    for (int g = gw; g < DEPTH * GL; g += NGW) {
        const int l = g / GL, gl = g - l * GL, sidx = gl < G0 ? 0 : (gl < G0 + G1 ? 1 : 2), rg = gl - (sidx == 0 ? 0 : (sidx == 1 ? G0 : G0 + G1)), c = l * 3 + sidx;
        const bf16_t* W = (const bf16_t*)(ws + WS_W + (size_t)l * W_LAYER + (sidx == 0 ? W_F1IN : (sidx == 1 ? W_IN : W_F2IN)));
        const int n = rg * 4 + (lane >> 4); const bf16_t* wrow = W + (size_t)n * D + sub * 8; const bf16_t* sp0 = sh16 + (size_t)c * 5 * D + sub * 8;
        float acc[5] = {0.f, 0.f, 0.f, 0.f, 0.f};
#pragma unroll 8
        for (int i = 0; i < 16; ++i) { const u32x4 w8 = __builtin_nontemporal_load((const u32x4*)(wrow + i * 128));
#pragma unroll
            for (int b = 0; b < 5; ++b) { const u32x4 s8 = *(const u32x4*)(sp0 + b * D + i * 128);
                acc[b] = DOT2(w8.x, s8.x, acc[b]); acc[b] = DOT2(w8.y, s8.y, acc[b]); acc[b] = DOT2(w8.z, s8.z, acc[b]); acc[b] = DOT2(w8.w, s8.w, acc[b]); } }
#pragma unroll
        for (int b = 0; b < 5; ++b) { float t = acc[b]; DPP_ADD(t, 0xB1); DPP_ADD(t, 0x4E); DPP_ADD(t, 0x141); DPP_ADD(t, 0x140);
            if (sub == 0) SW[(size_t)(c * 5 + b) * SWLD + n] = t; }
    }
    __syncthreads();
}

__device__ __forceinline__ void rinv_phase(const float* SSQ, float* RINV, int nrows, const int wv) {
    const int tidx = tid_of(wv), lane = tidx & 63, gt = blockIdx.x * 512 + tidx, NT = gridDim.x * 512;
    for (int i = gt; i < nrows * 8; i += NT) { const f32x4 a = *(const f32x4*)(SSQ + (size_t)i * 4); float v = (a[0] + a[1]) + (a[2] + a[3]);
        v += xlane(v, lane ^ 1); v += xlane(v, lane ^ 2); v += xlane(v, lane ^ 4);
        if ((lane & 7) == 0) RINV[i >> 3] = rsqrtf(v * (1.f / D) + EPS); }
}
struct CombResid { int nks; const hf_t* P; const float* base32; const hf_t* base16; hf_t* H; const float* gate; bf16_t* Z; const float* gnext; const float* scnext; float* RINV; float coef; int wz; };
__device__ __forceinline__ void ctx_combine_resid(const CombResid& a, float* lds_f, const int wv) {
    const int tidx = tid_of(wv), lane = tidx & 63, w = tidx >> 6, half = w & 1;
    for (int r0 = blockIdx.x * 4; r0 < RC; r0 += gridDim.x * 4) { const int r = r0 + (w >> 1); const size_t ro = (size_t)(RL + r) * LDP; float ss = 0.f;
#pragma unroll
        for (int jj = 0; jj < 4; ++jj) { const int col = (half * 4 + jj) * 256 + lane * 4;
            f32x4 acc = __builtin_convertvector(*(const h16x4*)(a.P + (size_t)r * D + col), f32x4);
#pragma unroll
            for (int ks = 1; ks < 8; ++ks) if (ks < a.nks) acc = acc + __builtin_convertvector(*(const h16x4*)(a.P + ((size_t)ks * RC + r) * D + col), f32x4);
            const f32x4 bs = a.base32 ? *(const f32x4*)(a.base32 + (size_t)r * D + col) : __builtin_convertvector(*(const h16x4*)(a.base16 + ro + col), f32x4);
            const f32x4 hv = bs + *(const f32x4*)(a.gate + (size_t)4 * MODW + col) * a.coef * acc;
            *(h16x4*)(a.H + ro + col) = __builtin_convertvector(hv, h16x4); ss += (hv[0] * hv[0] + hv[1] * hv[1]) + (hv[2] * hv[2] + hv[3] * hv[3]);
            if (a.wz) { const f32x4 z = hv * *(const f32x4*)(a.gnext + col) * (*(const f32x4*)(a.scnext + (size_t)4 * MODW + col) + 1.f); u32x2 w; w.x = cvt_pk_bf16(z[0], z[1]); w.y = cvt_pk_bf16(z[2], z[3]); *(u32x2*)(a.Z + ro + col) = w; } }
        ss = wave_sum(ss, lane);
        __syncthreads();
        if (lane == 0) lds_f[w] = ss;
        __syncthreads();
        if (lane == 0 && half == 0) a.RINV[RL + r] = rsqrtf((lds_f[w] + lds_f[w + 1]) * (1.f / D) + EPS); }
}
__device__ __forceinline__ void ctx_combine_u(const hf_t* P, const float* RINV, const float* sw, bf16_t* U, const int wv) {
    const int tidx = tid_of(wv), lane = tidx & 63, w = tidx >> 6, half = w & 1;
    for (int r = blockIdx.x * 4 + (w >> 1); r < RC; r += gridDim.x * 4) { const float rinv = RINV[RL + r];
#pragma unroll
        for (int jj = 0; jj < INCP / 512; ++jj) { const int col = (half * (INCP / 512) + jj) * 256 + lane * 4;
            f32x4 acc = __builtin_convertvector(*(const h16x4*)(P + (size_t)r * INCP + col), f32x4);
#pragma unroll
            for (int ks = 1; ks < 4; ++ks) acc = acc + __builtin_convertvector(*(const h16x4*)(P + ((size_t)ks * RC + r) * INCP + col), f32x4);
            const f32x4 v = acc * rinv + *(const f32x4*)(sw + (size_t)4 * SWLD + col);
            u32x2 w; w.x = cvt_pk_bf16(v[0], v[1]); w.y = cvt_pk_bf16(v[2], v[3]); *(u32x2*)(U + (size_t)(RL + r) * INCP + col) = w; } }
}
__device__ __forceinline__ void final_phase(const hf_t* H, const float* SSQ, float* out, const float* g, const int wv) {
    const int tidx = tid_of(wv), lane = tidx & 63, gw = blockIdx.x * 8 + (tidx >> 6), NGW = gridDim.x * 8;
    const f32x4* gp = (const f32x4*)g + lane;
    h16x4 cur[8]; float cs = 0.f;
    if (gw < RL) { const h16x4* hp = (const h16x4*)(H + (size_t)gw * LDP) + lane;
#pragma unroll
        for (int j = 0; j < 8; ++j) cur[j] = __builtin_nontemporal_load(hp + 64 * j);
        cs = lane < 32 ? SSQ[(size_t)gw * 32 + lane] : 0.f; }
    for (int row = gw; row < RL; row += NGW) {
        h16x4 nxt[8]; float ns = 0.f;
#pragma unroll
        for (int j = 0; j < 8; ++j) nxt[j] = cur[j];
        if (row + NGW < RL) { const h16x4* hp = (const h16x4*)(H + (size_t)(row + NGW) * LDP) + lane;
#pragma unroll
            for (int j = 0; j < 8; ++j) nxt[j] = __builtin_nontemporal_load(hp + 64 * j);
            ns = lane < 32 ? SSQ[(size_t)(row + NGW) * 32 + lane] : 0.f; }
        asm volatile("" ::: "memory");
        const float rinv = rsqrtf(wave_sum(cs, lane) * (1.f / D) + EPS);
        f32x4* op = (f32x4*)(out + (size_t)row * D) + lane;
#pragma unroll
        for (int j = 0; j < 8; ++j) op[64 * j] = __builtin_convertvector(cur[j], f32x4) * rinv * gp[64 * j];
#pragma unroll
        for (int j = 0; j < 8; ++j) cur[j] = nxt[j];
        cs = ns;
    }
}
struct PrepArgs { const bf16_t* U; bf16_t *QA, *KA, *VA, *BQN, *BKVN, *KB, *POOLED; const float *aqg, *akg, *bqg, *bkvg; const float* tab; };
struct PrepRaw { unsigned q1[8], q2[8], k1[2], k2[2], r1, r2; u32x2 av, bkv; bf16x8 bq; float cA, sA, cB, sB; };
__device__ __forceinline__ void prep_load(PrepRaw& r, const PrepArgs& a, int row, int lane) {
    const bf16_t* u = a.U + (size_t)row * INCP;
#pragma unroll
    for (int h = 0; h < 8; ++h) { r.q1[h] = __builtin_nontemporal_load(u + U_AQ + h * 128 + lane); r.q2[h] = __builtin_nontemporal_load(u + U_AQ + h * 128 + 64 + lane); }
#pragma unroll
    for (int h = 0; h < 2; ++h) { r.k1[h] = __builtin_nontemporal_load(u + U_AK + h * 128 + lane); r.k2[h] = __builtin_nontemporal_load(u + U_AK + h * 128 + 64 + lane); }
    r.av = __builtin_nontemporal_load((const u32x2*)(u + U_AV + lane * 4)); r.bq = __builtin_nontemporal_load((const bf16x8*)(u + U_BQ + lane * 8)); r.bkv = __builtin_nontemporal_load((const u32x2*)(u + U_BKV + lane * 4));
    r.r1 = u[U_BKR + (lane & 31)]; r.r2 = u[U_BKR + 32 + (lane & 31)];
    r.cA = 1.f; r.sA = 0.f; r.cB = 1.f; r.sB = 0.f;
    if (row < RL) { const int t = row & 4095, prow = t >> 6, pcol = t & 63; const float* cosA = a.tab; const float* sinA = a.tab + 2048; const float* cosB = a.tab + 4096; const float* sinB = a.tab + 4096 + 1024;
        const int ia = lane < 32 ? prow * 32 + lane : pcol * 32 + (lane - 32); r.cA = cosA[ia]; r.sA = sinA[ia];
        const int l5 = lane & 31, ib = l5 < 16 ? prow * 16 + l5 : pcol * 16 + (l5 - 16); r.cB = cosB[ib]; r.sB = sinB[ib]; }
}
__device__ __forceinline__ void prep_phase(const PrepArgs& a, const int wv) {
    const int tidx = tid_of(wv), lane = tidx & 63, gw = blockIdx.x * 8 + (tidx >> 6), NGW = gridDim.x * 8;
    { const float gq1 = a.aqg[lane], gq2 = a.aqg[64 + lane], gk1 = a.akg[lane], gk2 = a.akg[64 + lane];
      const f32x4 gb0 = *(const f32x4*)(a.bqg + lane * 8), gb1 = *(const f32x4*)(a.bqg + lane * 8 + 4), gkv = *(const f32x4*)(a.bkvg + lane * 4);
      PrepRaw cur; if (gw < R) prep_load(cur, a, gw, lane);
      for (int row = gw; row < R; row += NGW) {
        PrepRaw nxt = cur; if (row + NGW < R) prep_load(nxt, a, row + NGW, lane);
        asm volatile("" ::: "memory");
        size_t kvrow; if (row < RL) kvrow = (size_t)(row >> 12) * SKV + CTXL + (row & 4095); else { const int rc = row - RL; kvrow = (size_t)(rc >> 8) * SKV + (rc & 255); }
        const float cA = cur.cA, sA = cur.sA, cB = cur.cB, sB = cur.sB;
#pragma unroll
        for (int h = 0; h < 8; ++h) { const float x1 = bf2f((unsigned short)cur.q1[h]), x2 = bf2f((unsigned short)cur.q2[h]);
            const float rinv = rsqrtf(wave_sum(x1 * x1 + x2 * x2, lane) * (1.f / 128.f) + EPS); const float y1 = x1 * rinv * gq1, y2 = x2 * rinv * gq2;
            bf16_t* q = a.QA + (size_t)row * 1024 + h * 128; q[lane] = f2bf(y1 * cA - y2 * sA); q[64 + lane] = f2bf(y1 * sA + y2 * cA); }
#pragma unroll
        for (int h = 0; h < 2; ++h) { const float x1 = bf2f((unsigned short)cur.k1[h]), x2 = bf2f((unsigned short)cur.k2[h]);
            const float rinv = rsqrtf(wave_sum(x1 * x1 + x2 * x2, lane) * (1.f / 128.f) + EPS); const float y1 = x1 * rinv * gk1, y2 = x2 * rinv * gk2;
            bf16_t* k = a.KA + kvrow * 256 + h * 128; k[lane] = f2bf(y1 * cA - y2 * sA); k[64 + lane] = f2bf(y1 * sA + y2 * cA); }
        *(u32x2*)(a.VA + kvrow * 256 + lane * 4) = cur.av;
        { const bf16x8 q8 = cur.bq;
          const f32x4 v0 = {bf2f((unsigned short)q8[0]), bf2f((unsigned short)q8[1]), bf2f((unsigned short)q8[2]), bf2f((unsigned short)q8[3])}, v1 = {bf2f((unsigned short)q8[4]), bf2f((unsigned short)q8[5]), bf2f((unsigned short)q8[6]), bf2f((unsigned short)q8[7])};
          const float ss = (v0[0] * v0[0] + v0[1] * v0[1]) + (v0[2] * v0[2] + v0[3] * v0[3]) + (v1[0] * v1[0] + v1[1] * v1[1]) + (v1[2] * v1[2] + v1[3] * v1[3]);
          const float rinv = rsqrtf(wave_sum(ss, lane) * (1.f / 512.f) + EPS); const f32x4 o0 = v0 * rinv * gb0, o1 = v1 * rinv * gb1;
          u32x4 w; w.x = cvt_pk_bf16(o0[0], o0[1]); w.y = cvt_pk_bf16(o0[2], o0[3]); w.z = cvt_pk_bf16(o1[0], o1[1]); w.w = cvt_pk_bf16(o1[2], o1[3]);
          *(u32x4*)(a.BQN + (size_t)row * 512 + lane * 8) = w; }
        { const u32x2 k4 = cur.bkv; const f32x4 v = {__uint_as_float(k4.x << 16), __uint_as_float(k4.x & 0xffff0000u), __uint_as_float(k4.y << 16), __uint_as_float(k4.y & 0xffff0000u)};
          const float rinv = rsqrtf(wave_sum((v[0] * v[0] + v[1] * v[1]) + (v[2] * v[2] + v[3] * v[3]), lane) * (1.f / 256.f) + EPS);
          const f32x4 o = v * rinv * gkv; u32x2 w; w.x = cvt_pk_bf16(o[0], o[1]); w.y = cvt_pk_bf16(o[2], o[3]);
          *(u32x2*)(a.BKVN + (size_t)row * 256 + lane * 4) = w; }
        if (lane < 32) { const float x1 = bf2f((unsigned short)cur.r1), x2 = bf2f((unsigned short)cur.r2); const unsigned w = cvt_pk_bf16(x1 * cB - x2 * sB, x1 * sB + x2 * cB);
#pragma unroll
            for (int h = 0; h < 4; ++h) *(unsigned*)(a.KB + kvrow * 768 + h * 192 + 128 + 2 * lane) = w; }
        cur = nxt;
      } }
    { const int hw = 1 << (lane >> 4);
      for (int task = gw; task < R / 8; task += NGW) {
        const int row0 = task * 8; int t0, seqbase, L;
        if (row0 < RL) { t0 = row0 & 4095; seqbase = row0 - t0; L = SEQ; } else { const int rc = row0 - RL; t0 = rc & 255; seqbase = row0 - t0; L = CTXL; }
        bf16x8 xr[24];
#pragma unroll
        for (int jj = 0; jj < 24; ++jj) { int tj = t0 - 8 + jj; tj = tj < 0 ? 0 : (tj > L - 1 ? L - 1 : tj); xr[jj] = *(const bf16x8*)(a.U + (size_t)(seqbase + tj) * INCP + U_CU + lane * 8); }
#pragma unroll
        for (int i = 0; i < 8; ++i) { const int t = t0 + i; int lo = t - hw, hi = t + hw; lo = lo < 0 ? 0 : lo; hi = hi > L ? L : hi;
            float acc[8];
#pragma unroll
            for (int e = 0; e < 8; ++e) acc[e] = 0.f;
#pragma unroll
            for (int jj = i; jj < i + 16; ++jj) { const int tj = t0 - 8 + jj; const bool in = tj >= lo && tj < hi;
#pragma unroll
                for (int e = 0; e < 8; ++e) acc[e] += in ? bf2f((unsigned short)xr[jj][e]) : 0.f; }
            const float inv = 1.f / (float)(hi - lo); const bf16x8 c = xr[8 + i];
            u32x4 w; w.x = cvt_pk_bf16(acc[0] * inv - bf2f((unsigned short)c[0]), acc[1] * inv - bf2f((unsigned short)c[1])); w.y = cvt_pk_bf16(acc[2] * inv - bf2f((unsigned short)c[2]), acc[3] * inv - bf2f((unsigned short)c[3]));
            w.z = cvt_pk_bf16(acc[4] * inv - bf2f((unsigned short)c[4]), acc[5] * inv - bf2f((unsigned short)c[5])); w.w = cvt_pk_bf16(acc[6] * inv - bf2f((unsigned short)c[6]), acc[7] * inv - bf2f((unsigned short)c[7]));
            *(u32x4*)(a.POOLED + (size_t)(row0 + i) * 512 + lane * 8) = w; }
      } }
}
namespace att {
using f32x16 = __attribute__((ext_vector_type(16))) float;
using s16x4  = __attribute__((ext_vector_type(4))) short;
constexpr int QBLK = 32, KVBLK = 64, DV = 128;
constexpr float THR = 8.f;
constexpr int SHM_V = KVBLK * DV * 2;
#define SBAR() __builtin_amdgcn_sched_barrier(0)
__device__ __forceinline__ int crow(int r, int hi) { return (r & 3) + 8 * (r >> 2) + 4 * hi; }
template <int DK> struct Cst { static constexpr float SCALE = DK == 128 ? 0.088388347648318440f : 0.072168783648703220f; };
template <int DK>
__device__ __forceinline__ void partialSM(f32x16& p0, f32x16& p1, float& m_reg, float& mn, float& alpha) {
  constexpr float SCALE = Cst<DK>::SCALE, C = SCALE * 1.4426950408889634f;
  float pmax = p0[0];
#pragma unroll
  for (int r = 1; r < 16; ++r) pmax = fmaxf(pmax, p0[r]);
#pragma unroll
  for (int r = 0; r < 16; ++r) pmax = fmaxf(pmax, p1[r]);
  { auto rr = __builtin_amdgcn_permlane32_swap(__float_as_uint(pmax), __float_as_uint(pmax), false, false);
    pmax = fmaxf(__uint_as_float(rr[0]), __uint_as_float(rr[1])); }
  if (__builtin_expect(__all(pmax - m_reg <= THR / SCALE), 1)) { mn = m_reg; alpha = 1.f; }
  else { mn = fmaxf(m_reg, pmax); alpha = __builtin_amdgcn_exp2f((m_reg - mn) * C); m_reg = mn; }
  float mnC = -mn * C;
#pragma unroll
  for (int r = 0; r < 16; ++r) p0[r] = fmaf(p0[r], C, mnC);
#pragma unroll
  for (int r = 0; r < 16; ++r) p1[r] = fmaf(p1[r], C, mnC);
#pragma unroll
  for (int r = 0; r < 16; ++r) p0[r] = __builtin_amdgcn_exp2f(p0[r]);
}
__device__ __forceinline__ void finishSM(f32x16& p0, f32x16& p1, float alpha, float& l_reg, bf16x8& pa0, bf16x8& pa1, bf16x8& pa2, bf16x8& pa3) {
#pragma unroll
  for (int r = 0; r < 16; ++r) p1[r] = __builtin_amdgcn_exp2f(p1[r]);
  float ps = 0;
#pragma unroll
  for (int r = 0; r < 16; ++r) ps += p0[r];
#pragma unroll
  for (int r = 0; r < 16; ++r) ps += p1[r];
  { auto rr = __builtin_amdgcn_permlane32_swap(__float_as_uint(ps), __float_as_uint(ps), false, false);
    ps = __uint_as_float(rr[0]) + __uint_as_float(rr[1]); }
  l_reg = l_reg * alpha + ps;
#define PK4(P, BASE, OUT) do { unsigned a0 = cvt_pk_bf16(P[BASE + 0], P[BASE + 1]), a1 = cvt_pk_bf16(P[BASE + 2], P[BASE + 3]);   \
    unsigned b0 = cvt_pk_bf16(P[BASE + 4], P[BASE + 5]), b1 = cvt_pk_bf16(P[BASE + 6], P[BASE + 7]);                              \
    auto r0 = __builtin_amdgcn_permlane32_swap(a0, b0, false, false); auto r1 = __builtin_amdgcn_permlane32_swap(a1, b1, false, false); \
    u32x4 w = {r0[0], r1[0], r0[1], r1[1]}; OUT = *reinterpret_cast<bf16x8*>(&w); } while (0)
  PK4(p0, 0, pa0); PK4(p0, 8, pa1); PK4(p1, 0, pa2); PK4(p1, 8, pa3);
#undef PK4
}
template <int DK> __device__ __forceinline__ int kswz(int row, int colB) { return row * (DK * 2) + (colB ^ ((row & 7) << 4)); }
template <int DK, int NPARK>
__device__ __forceinline__ void qkt(f32x16& p0, f32x16& p1, const char* Ks, const bf16x8* qr, const char* qpark, int r32, int hi) {
  p0 = f32x16{}; p1 = f32x16{};
#pragma unroll
  for (int d0 = 0; d0 < DK / 16; ++d0) { const int cb = (d0 * 16 + hi * 8) * 2;
    bf16x8 b0 = *reinterpret_cast<const bf16x8*>(Ks + kswz<DK>(r32, cb));
    bf16x8 b1 = *reinterpret_cast<const bf16x8*>(Ks + kswz<DK>(32 + r32, cb));
    bf16x8 q;
    if constexpr (NPARK > 0) { if (d0 >= DK / 16 - NPARK) q = *reinterpret_cast<const bf16x8*>(qpark + (d0 - (DK / 16 - NPARK)) * 1024); else q = qr[d0]; } else q = qr[d0];
    p0 = __builtin_amdgcn_mfma_f32_32x32x16_bf16(b0, q, p0, 0, 0, 0);
    p1 = __builtin_amdgcn_mfma_f32_32x32x16_bf16(b1, q, p1, 0, 0, 0); }
}
__device__ __forceinline__ int v_st(int k, int c) { const int kk = (k & ~0xC) | ((k & 4) << 1) | ((k & 8) >> 1); return ((kk >> 3) * 4 + (c >> 5)) * 512 + ((kk & 7) * 32 + (c & 31)) * 2; }
__device__ __forceinline__ int v_rd_base(int lane) { return ((lane & 3) << 3) | (((lane >> 2) & 3) << 6) | (((lane >> 4) & 1) << 5) | (((lane >> 5) & 1) << 8); }
constexpr int v_rd_off(int d0, int ks, int half) { return d0 * 512 + ks * 4096 + half * 2048; }
template <int OFF> __device__ __forceinline__ s16x4 tr_read(int vb) {
  s16x4 r; asm volatile("ds_read_b64_tr_b16 %0, %1 offset:%2" : "=&v"(r) : "v"(vb), "i"(OFF) : "memory"); return r;
}
template <int D0> __device__ __forceinline__ void pv_one(f32x16& od, int vb, bf16x8 pa0, bf16x8 pa1, bf16x8 pa2, bf16x8 pa3) {
  const s16x4 l0 = tr_read<v_rd_off(D0, 0, 0)>(vb), h0 = tr_read<v_rd_off(D0, 0, 1)>(vb), l1 = tr_read<v_rd_off(D0, 1, 0)>(vb), h1 = tr_read<v_rd_off(D0, 1, 1)>(vb);
  const s16x4 l2 = tr_read<v_rd_off(D0, 2, 0)>(vb), h2 = tr_read<v_rd_off(D0, 2, 1)>(vb), l3 = tr_read<v_rd_off(D0, 3, 0)>(vb), h3 = tr_read<v_rd_off(D0, 3, 1)>(vb);
  asm volatile("s_waitcnt lgkmcnt(0)" ::: "memory"); SBAR();
#define PK(L, H) (bf16x8){L[0], L[1], L[2], L[3], H[0], H[1], H[2], H[3]}
  od = __builtin_amdgcn_mfma_f32_32x32x16_bf16(pa0, PK(l0, h0), od, 0, 0, 0);
  od = __builtin_amdgcn_mfma_f32_32x32x16_bf16(pa1, PK(l1, h1), od, 0, 0, 0);
  od = __builtin_amdgcn_mfma_f32_32x32x16_bf16(pa2, PK(l2, h2), od, 0, 0, 0);
  od = __builtin_amdgcn_mfma_f32_32x32x16_bf16(pa3, PK(l3, h3), od, 0, 0, 0);
#undef PK
}
__device__ __forceinline__ void pv_d0(f32x16* o, int vb, bf16x8 pa0, bf16x8 pa1, bf16x8 pa2, bf16x8 pa3) {
  pv_one<0>(o[0], vb, pa0, pa1, pa2, pa3); pv_one<1>(o[1], vb, pa0, pa1, pa2, pa3); pv_one<2>(o[2], vb, pa0, pa1, pa2, pa3); pv_one<3>(o[3], vb, pa0, pa1, pa2, pa3);
}
template <int DK, int LDQ, int LDK, int LDV, int LDO, int SDEPTH, int NPARK>
__device__ __forceinline__ void body(const bf16_t* __restrict__ Qb, const bf16_t* __restrict__ Kh, const bf16_t* __restrict__ Vh, bf16_t* __restrict__ Ob, int seq, char* lds, int tid, int wid) {
  constexpr int SHM_K = KVBLK * DK * 2, ND0 = DK / 16;
  const int lane = tid & 63, r32 = lane & 31, hi = lane >> 5;
  char* V_lds = lds; char* K_lds = lds + 2 * SHM_V;
  float* ws = (float*)(lds + 2 * SHM_V + 2 * SHM_K) + wid * 64; float* li_l = ws; float* al_l = ws + 32;
  float m_reg = -1e30f, l_reg = 0; f32x16 o[4] = {}; bf16x8 qr[ND0 - NPARK];
  const bf16_t* Qw = Qb + (long)(wid * QBLK + r32) * LDQ + hi * 8;
  char* qpark = lds + 2 * SHM_V + 2 * SHM_K + 2048 + wid * (NPARK * 1024) + lane * 16;
#pragma unroll
  for (int d0 = 0; d0 < ND0; ++d0) { const bf16x8 qv = *reinterpret_cast<const bf16x8*>(Qw + d0 * 16); if constexpr (NPARK > 0) { if (d0 >= ND0 - NPARK) *reinterpret_cast<bf16x8*>(qpark + (d0 - (ND0 - NPARK)) * 1024) = qv; else qr[d0] = qv; } else qr[d0] = qv; }
  const int sr = tid >> 4, sc = (tid & 15) * 8, vst0 = v_st(sr, sc), vst1 = v_st(32 + sr, sc);
  const int sr2 = tid >> 3, sc2 = 128 + (tid & 7) * 8;
  const int vb0 = (int)(uintptr_t)V_lds + v_rd_base(lane);
  struct { bf16x8 vs0, vs1, ks0, ks1, ks2; } sr_[SDEPTH];
  const unsigned ov0 = (unsigned)(sr * LDV + sc) * 2u, ov1 = (unsigned)((32 + sr) * LDV + sc) * 2u, ok0 = (unsigned)(sr * LDK + sc) * 2u, ok1 = (unsigned)((32 + sr) * LDK + sc) * 2u, ok2 = (unsigned)(sr2 * LDK + sc2) * 2u;
#define SLOAD(i, k0) do { const char* Vt_ = (const char*)Vh + (size_t)(k0) * (LDV * 2); const char* Kt_ = (const char*)Kh + (size_t)(k0) * (LDK * 2); \
    sr_[i].vs0 = *(const bf16x8*)(Vt_ + ov0); sr_[i].vs1 = *(const bf16x8*)(Vt_ + ov1); sr_[i].ks0 = *(const bf16x8*)(Kt_ + ok0); sr_[i].ks1 = *(const bf16x8*)(Kt_ + ok1); \
    if constexpr (DK == 192) sr_[i].ks2 = *(const bf16x8*)(Kt_ + ok2); } while (0)
#define SWRITE(b, i) do { *(bf16x8*)(V_lds + (b) * SHM_V + vst0) = sr_[i].vs0; *(bf16x8*)(V_lds + (b) * SHM_V + vst1) = sr_[i].vs1; const int kc = sc * 2; \
    *(bf16x8*)(K_lds + (b) * SHM_K + kswz<DK>(sr, kc)) = sr_[i].ks0; *(bf16x8*)(K_lds + (b) * SHM_K + kswz<DK>(32 + sr, kc)) = sr_[i].ks1; \
    if constexpr (DK == 192) *(bf16x8*)(K_lds + (b) * SHM_K + kswz<DK>(sr2, sc2 * 2)) = sr_[i].ks2; } while (0)
#define SWAIT() do { if constexpr (SDEPTH == 2) { if constexpr (DK == 192) asm volatile("s_waitcnt vmcnt(5)" ::: "memory"); else asm volatile("s_waitcnt vmcnt(4)" ::: "memory"); } else asm volatile("s_waitcnt vmcnt(0)" ::: "memory"); } while (0)
#define RESC(a) do { if (__any((a) < 1.f)) { if (hi == 0) al_l[r32] = (a); asm volatile("s_waitcnt lgkmcnt(0)" ::: "memory"); \
    _Pragma("unroll") for (int d = 0; d < 4; ++d) _Pragma("unroll") for (int r = 0; r < 16; ++r) o[d][r] *= al_l[crow(r, hi)]; } } while (0)
  f32x16 pA0, pA1, pB0, pB1; float mnA, mnB, alA, alB; bf16x8 pa0, pa1, pa2, pa3; const int NT = seq / KVBLK;
  constexpr int SE = 0, SO = SDEPTH - 1;
  SLOAD(SE, 0); asm volatile("s_waitcnt vmcnt(0)" ::: "memory"); SWRITE(0, SE); __syncthreads();
  qkt<DK, NPARK>(pA0, pA1, K_lds, qr, qpark, r32, hi); partialSM<DK>(pA0, pA1, m_reg, mnA, alA);
  SLOAD(SO, KVBLK); if constexpr (SDEPTH == 2) { if (2 < NT) SLOAD(SE, 2 * KVBLK); }
  SWAIT(); SWRITE(1, SO); __syncthreads();
  for (int j = 1; j + 1 < NT; j += 2) {
    SBAR(); qkt<DK, NPARK>(pB0, pB1, K_lds + SHM_K, qr, qpark, r32, hi);
    finishSM(pA0, pA1, alA, l_reg, pa0, pa1, pa2, pa3); SBAR();
    SLOAD(SO, (j + SDEPTH) * KVBLK); SBAR();
    pv_d0(o, vb0, pa0, pa1, pa2, pa3); partialSM<DK>(pB0, pB1, m_reg, mnB, alB);
    __syncthreads(); SWAIT(); SWRITE(0, SE);
    RESC(alB); __syncthreads();
    SBAR(); qkt<DK, NPARK>(pA0, pA1, K_lds, qr, qpark, r32, hi);
    finishSM(pB0, pB1, alB, l_reg, pa0, pa1, pa2, pa3); SBAR();
    if (SDEPTH == 1 || j + 3 < NT) SLOAD(SE, (j + 1 + SDEPTH) * KVBLK); SBAR();
    pv_d0(o, vb0 + (int)SHM_V, pa0, pa1, pa2, pa3); partialSM<DK>(pA0, pA1, m_reg, mnA, alA);
    __syncthreads(); SWAIT(); SWRITE(1, SO);
    RESC(alA); __syncthreads();
  }
  SBAR(); qkt<DK, NPARK>(pB0, pB1, K_lds + SHM_K, qr, qpark, r32, hi);
  finishSM(pA0, pA1, alA, l_reg, pa0, pa1, pa2, pa3); SBAR();
  pv_d0(o, vb0, pa0, pa1, pa2, pa3); partialSM<DK>(pB0, pB1, m_reg, mnB, alB);
  __syncthreads(); RESC(alB);
  finishSM(pB0, pB1, alB, l_reg, pa0, pa1, pa2, pa3); SBAR();
  pv_d0(o, vb0 + (int)SHM_V, pa0, pa1, pa2, pa3);
  if (hi == 0) li_l[r32] = l_reg; asm volatile("s_waitcnt lgkmcnt(0)" ::: "memory");
  float rli[16];
#pragma unroll
  for (int r = 0; r < 16; ++r) rli[r] = __builtin_amdgcn_rcpf(li_l[crow(r, hi)]);
  int r32e = r32, hie = hi; asm volatile("" : "+v"(r32e), "+v"(hie));
  bf16_t* Ow = Ob + (long)(wid * QBLK) * LDO;
#pragma unroll
  for (int r = 0; r < 16; ++r) { const int orow = crow(r, hie);
#pragma unroll
    for (int d0 = 0; d0 < 4; ++d0) Ow[(long)orow * LDO + d0 * 32 + r32e] = f2bf(o[d0][r] * rli[r]); }
#undef SLOAD
#undef SWRITE
#undef SWAIT
#undef RESC
}
static_assert(2 * SHM_V + 2 * KVBLK * 192 * 2 + 2048 + 8 * 8 * 1024 <= BAR_OFF, "MLA attention LDS fits below the barrier words");
}
struct AttnArgs { const bf16_t *QA, *KA, *VA, *QB, *KB, *VB; bf16_t* Y; };
__device__ __forceinline__ void attn_phase(const AttnArgs& a, bool ctxq, char* lds, const int wv) {
    const int tid = tid_of(wv), G = gridDim.x;
    const int nA = ctxq ? 544 : 512, nB = ctxq ? 272 : 256;
    for (int U = blockIdx.x; U < nA; U += G) {
        int b, hq, seq; long qrow;
        if (U < 512) { const int x = U & 7, j = (U >> 3) & 31, aa = (U >> 8) * 32 + j; b = x >> 1; hq = 4 * (x & 1) + (aa >> 4); qrow = (long)b * SEQ + (aa & 15) * 256; seq = SKV; }
        else { const int V = U - 512, x = V & 7; b = x >> 1; hq = 4 * (x & 1) + (V >> 3); qrow = (long)RL + b * CTXL; seq = CTXL; }
        const long kv = ((long)b * SKV) * 256 + (hq >> 2) * 128;
        att::body<128, 1024, 256, 256, LDP, 1, 0>(a.QA + qrow * 1024 + hq * 128, a.KA + kv, a.VA + kv, a.Y + qrow * LDP + hq * 128, seq, lds, opaque(tid), wv);
        __syncthreads();
    }
    for (int U = blockIdx.x; U < nB; U += G) {
        int b, h, seq; long qrow;
        if (U < 256) { const int x = U & 7, j = U >> 3; b = x >> 1; h = 2 * (x & 1) + (j >> 4); qrow = (long)b * SEQ + (j & 15) * 256; seq = SKV; }
        else { const int V = U - 256, x = V & 7; b = x >> 1; h = 2 * (x & 1) + (V >> 3); qrow = (long)RL + b * CTXL; seq = CTXL; }
        att::body<192, 768, 768, 512, LDP, 1, 4>(a.QB + qrow * 768 + h * 192, a.KB + ((long)b * SKV) * 768 + h * 192, a.VB + ((long)b * SKV) * 512 + h * 128, a.Y + qrow * LDP + 1024 + h * 128, seq, lds, opaque(tid), wv);
        __syncthreads();
    }
}

#ifndef REP_P0
#define REP_P0 0
#endif
#ifndef REP_THIN
#define REP_THIN 0
#endif
#ifndef REP_ATT
#define REP_ATT 0
#endif
#ifndef REP_FIN
#define REP_FIN 0
#endif
#ifndef REP_FOUT
#define REP_FOUT 0
#endif
#ifndef REP_MIX
#define REP_MIX 0
#endif
#define GEMM(g, S, E) pg8::gemm_phase<decltype(E), decltype(S), true, true>((LAS unsigned char*)lds, g, S, E, wv)
typedef const __attribute__((address_space(4))) Params* KParams;
__device__ __forceinline__ KParams kargs() { const __attribute__((address_space(4))) void* k = (const __attribute__((address_space(4))) void*)__builtin_amdgcn_kernarg_segment_ptr(); asm volatile("" : "+s"(k)); return (KParams)k; }
#define WSP(T, off) ((T*)(ws + (off)))
#define PH_BEGIN KParams kp = kargs(); unsigned char* ws = kp->ws; (void)ws; const int G = gridDim.x, bid = blockIdx.x; (void)G; (void)bid; \
    const unsigned char* wl = ws + WS_W + (size_t)layer * W_LAYER; (void)wl; const float* mod = WSP(float, WS_MOD) + (size_t)layer * 5 * MODW; (void)mod; pg8::StaticOrder S; (void)S;
__global__ void __launch_bounds__(512, 2) fwd_kernel(Params p) {
    extern __shared__ __attribute__((aligned(16))) unsigned char lds[];
    float* lds_f = (float*)lds;
    const int wv = __builtin_amdgcn_readfirstlane(threadIdx.x >> 6);
    if (threadIdx.x == 0) *(uint4*)(lds + BAR_OFF) = make_uint4(0u, 0u, 0u, 0u);
    __syncthreads();
    XcdBarrier bar = xcd_barrier_post((unsigned*)(p.ws + WS_CTL), (volatile LAS unsigned*)(lds + BAR_OFF));

    for (int rep = 0; rep <= REP_P0; ++rep)
    { unsigned char* ws = p.ws;
      if (blockIdx.x == 0) p0_tables(WSP(float, WS_TAB), wv);
      p0_mod(p, WSP(float, WS_MOD), lds_f, wv);
      __syncthreads();
      p0_weights(p, lds_f, wv); __syncthreads(); }
    xcd_barrier(bar, wv);
    for (int rep = 0; rep <= REP_P0; ++rep)
    { unsigned char* ws = p.ws;
      p0b_z0(p, WSP(float, WS_MOD), WSP(bf16_t, WS_XN), WSP(float, WS_SSQ), WSP(float, WS_RINV), wv);
      p0b_sw(ws, WSP(float, WS_MOD), WSP(float, WS_SW), lds_f, wv); }
    xcd_barrier(bar, wv);

#pragma unroll 1
    for (int layer = 0; layer < DEPTH; ++layer) {
        const int Mo = layer == 0 ? R : RL;
        { PH_BEGIN pg8::Gemm g{WSP(bf16_t, WS_XN), (const bf16_t*)(wl + W_F1IN), R, 2 * DFF, D, LDP, D}; S.init(R, 2 * DFF, G, bid, D);
            EpiSwiglu E{WSP(bf16_t, WS_ACT), WSP(float, WS_RINV), WSP(float, WS_SW) + (size_t)(layer * 3 + 0) * 5 * SWLD}; GEMM(g, S, E); }
        xcd_barrier(bar, wv);
        if (layer == 0) { PH_BEGIN pg8::Gemm g{WSP(bf16_t, WS_ACT), (const bf16_t*)(wl + W_F1OUT), R, D, DFF, DFF}; pg8::MixOrder MS; MS.init(D, DFF, 8, G, bid, true);
            EpiMix<EpiResid<true, true>> E{{WSP(hf_t, WS_H), kp->in[I_X], kp->in[I_X], mod + 2 * D, WSP(bf16_t, WS_XN), kp->in[I_NORMG] + (size_t)layer * 3 * D + D, mod + 4 * D, WSP(float, WS_SSQ), 0.5f, 0.f}, {WSP(hf_t, WS_PART), D}}; GEMM(g, MS, E); }
        else { PH_BEGIN pg8::Gemm g{WSP(bf16_t, WS_ACT), (const bf16_t*)(wl + W_F1OUT), R, D, DFF, DFF}; pg8::MixOrder MS; MS.init(D, DFF, 8, G, bid, true);
            EpiMix<EpiResid<true, false>> E{{WSP(hf_t, WS_H), WSP(hf_t, WS_H), WSP(hf_t, WS_H), mod + 2 * D, WSP(bf16_t, WS_XN), kp->in[I_NORMG] + (size_t)layer * 3 * D + D, mod + 4 * D, WSP(float, WS_SSQ), 0.5f, 0.f}, {WSP(hf_t, WS_PART), D}}; GEMM(g, MS, E); }
        xcd_barrier(bar, wv);
        { PH_BEGIN rinv_phase(WSP(float, WS_SSQ), WSP(float, WS_RINV), RL, wv);
            CombResid a{8, WSP(hf_t, WS_PART), layer == 0 ? kp->in[I_CTX] : nullptr, WSP(hf_t, WS_H), WSP(hf_t, WS_H), mod + 2 * D, WSP(bf16_t, WS_XN), kp->in[I_NORMG] + (size_t)layer * 3 * D + D, mod + 4 * D, WSP(float, WS_RINV), 0.5f, 1};
            ctx_combine_resid(a, (float*)lds, wv); }
        xcd_barrier(bar, wv);
        { PH_BEGIN pg8::Gemm g{WSP(bf16_t, WS_XN), (const bf16_t*)(wl + W_IN), R, INCP, D, LDP, D}; pg8::MixOrder MS; MS.init(INCP, D, 4, G, bid, true);
            EpiMix<EpiU> E{{WSP(bf16_t, WS_U), WSP(float, WS_RINV), WSP(float, WS_SW) + (size_t)(layer * 3 + 1) * 5 * SWLD}, {WSP(hf_t, WS_PART), INCP}}; GEMM(g, MS, E); }
        xcd_barrier(bar, wv);
        { PH_BEGIN ctx_combine_u(WSP(hf_t, WS_PART), WSP(float, WS_RINV), WSP(float, WS_SW) + (size_t)(layer * 3 + 1) * 5 * SWLD, WSP(bf16_t, WS_U), wv); }
        xcd_barrier(bar, wv);
        for (int rep = 0; rep <= REP_THIN; ++rep) { PH_BEGIN PrepArgs a{WSP(bf16_t, WS_U), WSP(bf16_t, WS_QA), WSP(bf16_t, WS_KA), WSP(bf16_t, WS_VA), WSP(bf16_t, WS_BQN), WSP(bf16_t, WS_BKVN), WSP(bf16_t, WS_KB), WSP(bf16_t, WS_POOL),
                              kp->in[I_AQG] + layer * 128, kp->in[I_AKG] + layer * 128, kp->in[I_BQG] + layer * 512, kp->in[I_BKVG] + layer * 256, WSP(float, WS_TAB)}; prep_phase(a, wv); }
        xcd_barrier(bar, wv);
        { PH_BEGIN pg8::Gemm g{WSP(bf16_t, WS_BQN), (const bf16_t*)(wl + W_UQ), R, 768, 512, 512}; S.init(R, 768, G, bid, 512); EpiUq E{WSP(bf16_t, WS_QB), WSP(float, WS_TAB) + 4096, WSP(float, WS_TAB) + 4096 + 1024}; GEMM(g, S, E); }
        { PH_BEGIN pg8::Gemm g{WSP(bf16_t, WS_BKVN), (const bf16_t*)(wl + W_UKV), R, 1024, 256, 256}; S.init(R, 1024, G, (bid + 204) % G, 256); EpiUkv E{WSP(bf16_t, WS_KB), WSP(bf16_t, WS_VB)}; GEMM(g, S, E); }
        { PH_BEGIN pg8::Gemm g{WSP(bf16_t, WS_POOL), (const bf16_t*)(wl + W_PL), R, 512, 512, 512}; S.init(R, 512, G, (bid + 220) % G, 512); EpiPool E{WSP(bf16_t, WS_Y)}; GEMM(g, S, E); }
        xcd_barrier(bar, wv);
        for (int rep = 0; rep <= REP_ATT; ++rep) { PH_BEGIN AttnArgs a{WSP(bf16_t, WS_QA), WSP(bf16_t, WS_KA), WSP(bf16_t, WS_VA), WSP(bf16_t, WS_QB), WSP(bf16_t, WS_KB), WSP(bf16_t, WS_VB), WSP(bf16_t, WS_Y)}; attn_phase(a, layer == 0, (char*)lds, wv); }
        xcd_barrier(bar, wv);
        { PH_BEGIN pg8::Gemm g{WSP(bf16_t, WS_Y), (const bf16_t*)(wl + W_OUT), R, D, D, LDP, D}; pg8::MixOrder MS; MS.init(D, D, 8, G, bid, layer == 0);
            EpiMix<EpiResid<true, false>> E{{WSP(hf_t, WS_H), WSP(hf_t, WS_H), WSP(hf_t, WS_H), mod + 5 * D, WSP(bf16_t, WS_XN), kp->in[I_NORMG] + (size_t)layer * 3 * D + 2 * D, mod + 7 * D, WSP(float, WS_SSQ), 1.0f, 0.f}, {WSP(hf_t, WS_PART), D}}; GEMM(g, MS, E); }
        xcd_barrier(bar, wv);
        { PH_BEGIN rinv_phase(WSP(float, WS_SSQ), WSP(float, WS_RINV), RL, wv);
            if (layer == 0) { CombResid a{8, WSP(hf_t, WS_PART), nullptr, WSP(hf_t, WS_H), WSP(hf_t, WS_H), mod + 5 * D, WSP(bf16_t, WS_XN), kp->in[I_NORMG] + (size_t)layer * 3 * D + 2 * D, mod + 7 * D, WSP(float, WS_RINV), 1.0f, 1};
                ctx_combine_resid(a, (float*)lds, wv); } }
        xcd_barrier(bar, wv);
        { PH_BEGIN pg8::Gemm g{WSP(bf16_t, WS_XN), (const bf16_t*)(wl + W_F2IN), Mo, 2 * DFF, D, LDP, D}; S.init(Mo, 2 * DFF, G, bid, D);
            EpiSwiglu E{WSP(bf16_t, WS_ACT), WSP(float, WS_RINV), WSP(float, WS_SW) + (size_t)(layer * 3 + 2) * 5 * SWLD}; GEMM(g, S, E); }
        xcd_barrier(bar, wv);
        if (layer + 1 < DEPTH) {
            { PH_BEGIN pg8::Gemm g{WSP(bf16_t, WS_ACT), (const bf16_t*)(wl + W_F2OUT), R, D, DFF, DFF}; pg8::MixOrder MS; MS.init(D, DFF, 8, G, bid, true);
                EpiMix<EpiResid<true, false>> E{{WSP(hf_t, WS_H), WSP(hf_t, WS_H), WSP(hf_t, WS_H), mod + 8 * D, WSP(bf16_t, WS_XN), kp->in[I_NORMG] + (size_t)(layer + 1) * 3 * D, mod + 5 * MODW + 1 * D, WSP(float, WS_SSQ), 0.5f, 0.f}, {WSP(hf_t, WS_PART), D}}; GEMM(g, MS, E); }
            xcd_barrier(bar, wv);
            { PH_BEGIN rinv_phase(WSP(float, WS_SSQ), WSP(float, WS_RINV), RL, wv);
                CombResid a{8, WSP(hf_t, WS_PART), nullptr, WSP(hf_t, WS_H), WSP(hf_t, WS_H), mod + 8 * D, WSP(bf16_t, WS_XN), kp->in[I_NORMG] + (size_t)(layer + 1) * 3 * D, mod + 5 * MODW + 1 * D, WSP(float, WS_RINV), 0.5f, 1};
                ctx_combine_resid(a, (float*)lds, wv); }
            xcd_barrier(bar, wv);
        } else {
            { PH_BEGIN pg8::Gemm g{WSP(bf16_t, WS_ACT), (const bf16_t*)(wl + W_F2OUT), RL, D, DFF, DFF}; S.init(RL, D, G, bid, DFF);
                EpiResid<false, false> E{WSP(hf_t, WS_H), WSP(hf_t, WS_H), WSP(hf_t, WS_H), mod + 8 * D, nullptr, nullptr, nullptr, WSP(float, WS_SSQ), 0.5f, 0.f}; GEMM(g, S, E); }
            xcd_barrier(bar, wv);
        }
    }
    for (int rep = 0; rep <= REP_THIN; ++rep) { const int layer = 0; PH_BEGIN final_phase(WSP(hf_t, WS_H), WSP(float, WS_SSQ), kp->out, kp->in[I_FINALG], wv); }
}

extern "C" void kernel_launch(void* const* d_in, const int* in_sizes, int n_in, void* d_out, int out_size, void* d_ws, size_t ws_size, hipStream_t stream) {
    static int grid = 0;
    if (grid == 0) {
        if (n_in != 22 || out_size != RL * D || ws_size < WS_END) { fprintf(stderr, "kernel_launch: shape mismatch: n_in %d out %d ws %zu (need %zu)\n", n_in, out_size, ws_size, (size_t)WS_END); grid = -1; return; }
        int dev = 0, cus = 0, per_cu = 0;
        if (hipGetDevice(&dev) != hipSuccess || hipDeviceGetAttribute(&cus, hipDeviceAttributeMultiprocessorCount, dev) != hipSuccess) { grid = -1; return; }
        if (hipFuncSetAttribute((const void*)fwd_kernel, hipFuncAttributeMaxDynamicSharedMemorySize, LDS_BYTES) != hipSuccess) { fprintf(stderr, "kernel_launch: hipFuncSetAttribute failed\n"); grid = -1; return; }
        if (hipOccupancyMaxActiveBlocksPerMultiprocessor(&per_cu, (const void*)fwd_kernel, 512, LDS_BYTES) != hipSuccess || per_cu < 1) { fprintf(stderr, "kernel_launch: occupancy query says %d\n", per_cu); }
        (void)hipGetLastError();
        grid = cus;
    }
    if (grid < 0) return;
    if (hipMemsetAsync((char*)d_ws + WS_CTL, 0, CTL_BYTES, stream) != hipSuccess) return;
    Params p{};
    for (int i = 0; i < 22; ++i) p.in[i] = (const float*)d_in[i];
    p.out = (float*)d_out; p.ws = (unsigned char*)d_ws;
    hipLaunchKernelGGL(fwd_kernel, dim3(grid), dim3(512), LDS_BYTES, stream, p);
}
```

```cpp
#include <hip/hip_runtime.h>
#include <cstdio>
#include <cstdint>

#define LAS __attribute__((address_space(3)))
typedef unsigned short bf16_t;
typedef short bf16x8 __attribute__((ext_vector_type(8)));
typedef float f32x4 __attribute__((ext_vector_type(4)));
typedef unsigned u32x4 __attribute__((ext_vector_type(4)));
typedef unsigned u32x2 __attribute__((ext_vector_type(2)));
typedef _Float16 hf_t;
typedef _Float16 h16x4 __attribute__((ext_vector_type(4)));
typedef _Float16 h16x8 __attribute__((ext_vector_type(8)));

constexpr int D = 2048, NB = 4, SEQ = 4096, CTXL = 256, DEPTH = 2;
constexpr int RL = NB * SEQ;
constexpr int RC = NB * CTXL;
constexpr int R = RL + RC;
constexpr int SKV = CTXL + SEQ;
constexpr int DFF = 5632, MODW = 9 * D;
constexpr int INC = 2880, INCP = 3072;
constexpr int U_AQ = 0, U_AK = 1024, U_AV = 1280, U_BQ = 1536, U_BKV = 2048, U_BKR = 2304, U_CU = 2368;
constexpr float EPS = 1e-6f;
constexpr int LDP = D + 64;

constexpr size_t MiB = 1u << 20;
constexpr size_t al256(size_t x) { return (x + 255) / 256 * 256; }
constexpr size_t WS_CTL = 0, CTL_BYTES = 64 * 1024;
constexpr size_t WS_TAB = WS_CTL + CTL_BYTES;
constexpr size_t WS_MOD = WS_TAB + 64 * 1024;
constexpr int SWLD = 2 * DFF;
constexpr size_t WS_SW = al256(WS_MOD + (size_t)DEPTH * 5 * MODW * 4);
constexpr size_t WS_SSQ = WS_SW + (size_t)DEPTH * 3 * 5 * SWLD * 4;
constexpr size_t WS_RINV = WS_SSQ + (size_t)R * 32 * 4;
constexpr size_t WS_H = al256(WS_RINV + (size_t)R * 4);
constexpr size_t WS_XN = WS_H + (size_t)R * D * 4;
constexpr size_t WS_ACT = WS_XN + (size_t)R * LDP * 2;
constexpr size_t WS_U = WS_ACT;
constexpr size_t WS_QA = WS_U + (size_t)R * INCP * 4;
constexpr size_t WS_KA = WS_QA + (size_t)R * 1024 * 2;
constexpr size_t WS_VA = WS_KA + (size_t)NB * SKV * 256 * 2;
constexpr size_t WS_QB = WS_VA + (size_t)NB * SKV * 256 * 2;
constexpr size_t WS_KB = WS_QB + (size_t)R * 768 * 2;
constexpr size_t WS_VB = WS_KB + (size_t)NB * SKV * 768 * 2;
constexpr size_t WS_BQN = WS_VB + (size_t)NB * SKV * 512 * 2;
constexpr size_t WS_BKVN = WS_BQN + (size_t)R * 512 * 2;
constexpr size_t WS_POOL = WS_BKVN + (size_t)R * 256 * 2;
constexpr size_t WS_Y = WS_POOL + (size_t)R * 512 * 2;
constexpr size_t WS_W = WS_Y + (size_t)R * LDP * 2;
constexpr size_t W_F1IN = 0, W_F1OUT = W_F1IN + (size_t)2 * DFF * D * 2, W_IN = W_F1OUT + (size_t)D * DFF * 2, W_OUT = W_IN + (size_t)INCP * D * 2,
                 W_F2IN = W_OUT + (size_t)D * D * 2, W_F2OUT = W_F2IN + (size_t)2 * DFF * D * 2, W_UQ = W_F2OUT + (size_t)D * DFF * 2, W_UKV = W_UQ + (size_t)768 * 512 * 2,
                 W_PL = W_UKV + (size_t)1024 * 256 * 2, W_LAYER = W_PL + (size_t)512 * 512 * 2;
constexpr size_t WS_PART = WS_W + DEPTH * W_LAYER;
constexpr size_t WS_END = WS_PART + (size_t)8 * RC * D * 4;
static_assert(WS_ACT + (size_t)R * DFF * 2 <= WS_QA, "ACT fits in the U region");

constexpr int LDS_BYTES = 155648;
constexpr int BAR_OFF = LDS_BYTES - 16;

__device__ __forceinline__ unsigned cvt_pk_bf16(float lo, float hi) { unsigned r; asm volatile("v_cvt_pk_bf16_f32 %0, %1, %2" : "=v"(r) : "v"(lo), "v"(hi)); return r; }
__device__ __forceinline__ bf16_t f2bf(float x) { return (bf16_t)(cvt_pk_bf16(x, 0.f) & 0xffffu); }
__device__ __forceinline__ float bf2f(unsigned short x) { return __uint_as_float(((unsigned)x) << 16); }
__device__ __forceinline__ float wave_sum(float v, int lane) {
#pragma unroll
    for (int o = 1; o < 64; o <<= 1) v += __uint_as_float(__builtin_amdgcn_ds_bpermute((lane ^ o) << 2, __float_as_uint(v)));
    return v;
}
__device__ __forceinline__ float wave_max(float v, int lane) {
#pragma unroll
    for (int o = 1; o < 64; o <<= 1) v = fmaxf(v, __uint_as_float(__builtin_amdgcn_ds_bpermute((lane ^ o) << 2, __float_as_uint(v))));
    return v;
}
__device__ __forceinline__ int opaque(int x) { asm volatile("" : "+v"(x)); return x; }
__device__ __forceinline__ int tid_of(int wave_s) { int w = wave_s; asm volatile("" : "+s"(w)); int l; asm volatile("v_mbcnt_lo_u32_b32 %0, -1, 0\n\tv_mbcnt_hi_u32_b32 %0, -1, %0" : "=v"(l)); return w * 64 + l; }
__device__ __forceinline__ float xlane(float v, int src_lane) { return __uint_as_float(__builtin_amdgcn_ds_bpermute(src_lane << 2, __float_as_uint(v))); }
__device__ __forceinline__ u32x4 gather4(u32x4 v, int idx4) { u32x4 r; r.x = (unsigned)__builtin_amdgcn_ds_bpermute(idx4, (int)v.x); r.y = (unsigned)__builtin_amdgcn_ds_bpermute(idx4, (int)v.y);
    r.z = (unsigned)__builtin_amdgcn_ds_bpermute(idx4, (int)v.z); r.w = (unsigned)__builtin_amdgcn_ds_bpermute(idx4, (int)v.w); return r; }
__device__ __forceinline__ float silu(float a) { return a * __builtin_amdgcn_rcpf(1.f + __builtin_amdgcn_exp2f(a * -1.4426950408889634f)); }

#define XB_TMO      128
#define XB_XCNT(j)  (256  + 64 * (j))
#define XB_XSUB(j)  (1280 + 64 * (j))
#define XB_XGEN(j)  (2304 + 64 * (j))
#define XB_TOP      3328
#define XB_TOPGEN   3392
#define XCD_BAR_WORDS 3456
#define XB_SPIN_CAP (1u << 22)

__device__ __forceinline__ unsigned xb_ld(unsigned* p)              { return __hip_atomic_load(p, __ATOMIC_RELAXED, __HIP_MEMORY_SCOPE_AGENT); }
__device__ __forceinline__ unsigned xb_add(unsigned* p, unsigned v) { return __hip_atomic_fetch_add(p, v, __ATOMIC_RELAXED, __HIP_MEMORY_SCOPE_AGENT); }
__device__ __forceinline__ unsigned xb_xcc_id() { return (unsigned)__builtin_amdgcn_s_getreg((3 << 11) | 20) & 0xFu; }
#define XB_SPIN(cond, bar) do { unsigned _sp = 0; while (cond) { __builtin_amdgcn_s_sleep(1); \
    if ((++_sp & 255u) == 0u) { if (xb_ld(&(bar)[XB_TMO])) break; if (_sp > XB_SPIN_CAP) { atomicAdd(&(bar)[XB_TMO], 1u); break; } } } } while (0)

struct XcdBarrier { unsigned* bar; unsigned x; volatile LAS unsigned* st; };

__device__ __forceinline__ XcdBarrier xcd_barrier_post(unsigned* bar, volatile LAS unsigned* st) {
    XcdBarrier b; b.bar = bar; b.x = xb_xcc_id(); b.st = st;
    if (threadIdx.x == 0) (void)xb_add(&bar[XB_XCNT(b.x)], 1u);
    return b;
}
__device__ __forceinline__ void xcd_barrier_complete(unsigned* bar, unsigned x, unsigned& nloc, unsigned& nx) {
    const unsigned G = gridDim.x * gridDim.y * gridDim.z;
    unsigned sum, cnt, mine, sp = 0u;
    for (;;) {
        sum = 0u; cnt = 0u; mine = 0u;
#pragma unroll
        for (unsigned j = 0; j < 16; ++j) { const unsigned c = xb_ld(&bar[XB_XCNT(j)]); sum += c; cnt += (c > 0u) ? 1u : 0u; mine = (j == x) ? c : mine; }
        if (sum == G) break;
        __builtin_amdgcn_s_sleep(1);
        if ((++sp & 255u) == 0u) { if (xb_ld(&bar[XB_TMO])) break; if (sp > XB_SPIN_CAP) { atomicAdd(&bar[XB_TMO], 1u); break; } }
    }
    nloc = mine > 0u ? mine : 1u; nx = cnt > 0u ? cnt : 1u;
}
__device__ __forceinline__ void xcd_barrier(const XcdBarrier& b, const int wv) {
    asm volatile("s_waitcnt vmcnt(0)" ::: "memory");
    __syncthreads();
    if (tid_of(wv) == 0) {
        unsigned* bar = b.bar; asm volatile("" : "+s"(bar)); unsigned bx = __builtin_amdgcn_readfirstlane(b.x); asm volatile("" : "+s"(bx));
        __builtin_amdgcn_s_waitcnt(0);
        unsigned nloc = b.st[0], nx = b.st[1];
        if (nloc == 0u) { xcd_barrier_complete(bar, bx, nloc, nx); b.st[0] = nloc; b.st[1] = nx; }
        const unsigned old = xb_add(&bar[XB_XSUB(bx)], 1u);
        const unsigned gen = old / nloc;
        if (old + 1u == (gen + 1u) * nloc) {
            __builtin_amdgcn_fence(__ATOMIC_RELEASE, "agent");
            asm volatile("s_waitcnt vmcnt(0)" ::: "memory");
            const unsigned og = xb_add(&bar[XB_TOP], 1u);
            const unsigned tg = og / nx;
            if (og + 1u == (tg + 1u) * nx) xb_add(&bar[XB_TOPGEN], 1u);
            else XB_SPIN(xb_ld(&bar[XB_TOPGEN]) == tg, bar);
            __builtin_amdgcn_fence(__ATOMIC_ACQUIRE, "agent");
            xb_add(&bar[XB_XGEN(bx)], 1u);
            asm volatile("s_waitcnt vmcnt(0)" ::: "memory");
        } else {
            XB_SPIN(xb_ld(&bar[XB_XGEN(bx)]) == gen, bar);
            __builtin_amdgcn_fence(__ATOMIC_ACQUIRE, "agent");
            asm volatile("s_waitcnt vmcnt(0)" ::: "memory");
        }
    }
    __syncthreads();
}

namespace pg8 {
#define PG8_LAS __attribute__((address_space(3)))
constexpr int BM = 256, BK = 64, HALF = 128, HTB = HALF * BK * 2  , STAGE_BYTES = 8 * HTB, NXCD = 8, WGM = 8;

__host__ __device__ __forceinline__ int lds_byte(int r, int c) { const int st = (r >> 4) * 2 + (c >> 5), rr = r & 15, cc = c & 31, ob = rr * 64 + cc * 2; return st * 1024 + (ob ^ (((ob >> 9) & 1) << 5)); }
__host__ __device__ __forceinline__ void stage_rc(int b, int& R, int& C) { const int st = b / 1024, sb = b % 1024, swz = sb ^ (((sb >> 9) & 1) << 5); R = (st >> 1) * 16 + swz / 64; C = (st & 1) * 32 + (swz % 64) / 2; }
__host__ __device__ __forceinline__ int perm32(int rho) { const int n = rho >> 4, i = rho & 15; return 8 * (i >> 2) + 4 * n + (i & 3); }

struct Unit { int pm, pn, ko, nk, ks; };
struct Gemm { const bf16_t* A; const bf16_t* Bt; int M, N, K, ld, ldb; };
struct StaticOrder {
    int nM, nN, nwg, G, c, nk;
    __host__ __device__ void init(int M, int N, int G_, int c_, int K_) { nM = M / BM; nN = N / BM; nwg = nM * nN; G = G_; c = c_; nk = K_ / 64; }
    __host__ __device__ __forceinline__ bool next(int i, Unit& u) const {
        const long L = (long)i * G + c; if (L >= nwg) return false;
        int wgid = (int)L; { const int q = nwg / NXCD, r = nwg % NXCD, xcd = wgid % NXCD, off = wgid / NXCD; wgid = (xcd < r ? xcd * (q + 1) : r * (q + 1) + (xcd - r) * q) + off; }
        const int nig = WGM * nN, gid = wgid / nig, fm = gid * WGM, gsz = (nM - fm) < WGM ? (nM - fm) : WGM;
        u.pm = fm + ((wgid % nig) % gsz); u.pn = (wgid % nig) / gsz; u.ko = 0; u.nk = nk; return true;
    }
    __device__ __forceinline__ unsigned code(int i, unsigned& ko_) const { Unit u; u.pm = 0; u.pn = 0; u.ko = 0; u.nk = 0; u.ks = 0; const bool ok = next(i, u); ko_ = (unsigned)u.ko; return ok ? (0x80000000u | ((unsigned)u.nk << 16) | ((unsigned)u.pm << 8) | (unsigned)u.pn) : 0u; }
    __device__ __forceinline__ void a_ready(const Unit&) const {}
    __device__ __forceinline__ void done(const Unit&) const {}
};
struct MixOrder {
    StaticOrder lat; int nN, nks, nlat, nsp, t1, t2;
    __host__ __device__ void init(int N, int K, int nks_, int G_, int c_, bool with_ctx) { lat.init(64 * BM, N, G_, c_, K); nN = N / BM; nks = nks_; nlat = 64 * nN; nsp = with_ctx ? 4 * nN * nks : 0;
        const int pair = (K / 64) / (nks_ / 2); t1 = ((pair / 2 + 1) / 2) * 2; t2 = pair - t1; }
    __device__ __forceinline__ unsigned code(int i, unsigned& ko_) const {
        const int L = i * lat.G + lat.c; if (L < nlat) return lat.code(i, ko_);
        const int Lp = L - nlat; if (Lp >= nsp) { ko_ = 0u; return 0u; }
        const int r = Lp / nks, ks = Lp % nks; ko_ = (unsigned)(((ks >> 1) * (t1 + t2) + (ks & 1) * t1) * 64);
        return 0x80000000u | ((unsigned)ks << 24) | ((unsigned)((ks & 1) ? t2 : t1) << 16) | ((unsigned)(64 + (r & 3)) << 8) | (unsigned)(r >> 2);
    }
    __device__ __forceinline__ void a_ready(const Unit&) const {}
    __device__ __forceinline__ void done(const Unit&) const {}
};
template <class Epi, class Sched, bool ALIGN_EPI = false, bool SP2 = false>
__device__ __forceinline__ void gemm_phase(PG8_LAS unsigned char* lds, const Gemm g, const Sched& S, const Epi& E, const int wv) {
    int wid_ = wv; asm volatile("" : "+s"(wid_));
    const int tid = tid_of(wv), wid = wid_, lane = tid & 63, wr = wid >> 2, wc = wid & 3, fr = lane & 15, fq = lane >> 4;
    const int K = g.ld, Kb = g.ldb ? g.ldb : g.ld;
    unsigned voffA[2], voffB[2];
#pragma unroll
    for (int i = 0; i < 2; ++i) { int R, C; stage_rc(tid * 16 + i * 8192, R, C); const int Rb = Epi::PERM ? ((R & ~31) + perm32(R & 31)) : R;
        voffA[i] = (unsigned)(R * K + C) * 2u; voffB[i] = (unsigned)(Rb * Kb + C) * 2u; }
    const size_t kstep = (size_t)(BK * 2);
    const size_t hstepA = (size_t)HALF * K * 2, hstepB = (size_t)HALF * Kb * 2;
    const size_t tstepA = 2 * hstepA, tstepB = 2 * hstepB;
    const unsigned ldsw = (unsigned)wid * 1024u;
    const unsigned ldsb = (unsigned)(size_t)lds + ldsw;
    const int aoff = lds_byte(wr * 64 + fr, fq * 8), boff = lds_byte(wc * 32 + fr, fq * 8);
#define PG8_SA(b, h) (((b) * 2 + (h)) * HTB)
#define PG8_SB(b, h) ((4 + (b) * 2 + (h)) * HTB)
#define PG8_STAGE(bufoff, gbase, voff) do { _Pragma("unroll") for (int _i = 0; _i < 2; ++_i) \
        asm volatile("s_mov_b32 m0, %0\n\ts_nop 0\n\tglobal_load_lds_dwordx4 %1, %2" :: "s"(ldsb + (unsigned)((bufoff) + _i * 8192)), "v"((voff)[_i]), "s"(gbase) : "m0", "memory"); } while (0)
#define PG8_LDA(dst, b, h) do { _Pragma("unroll") for (int m = 0; m < 4; ++m) _Pragma("unroll") for (int k = 0; k < 2; ++k) dst[m][k] = *(const PG8_LAS bf16x8*)(lds + PG8_SA(b, h) + aoff + m * 2048 + k * 1024); } while (0)
#define PG8_LDB(dst, b, h) do { _Pragma("unroll") for (int n = 0; n < 2; ++n) _Pragma("unroll") for (int k = 0; k < 2; ++k) dst[n][k] = *(const PG8_LAS bf16x8*)(lds + PG8_SB(b, h) + boff + n * 2048 + k * 1024); } while (0)
#define PG8_MMA(ai, bj, At, Bt) do { __builtin_amdgcn_s_setprio(1); _Pragma("unroll") for (int m = 0; m < 4; ++m) _Pragma("unroll") for (int n = 0; n < 2; ++n) _Pragma("unroll") for (int k = 0; k < 2; ++k) \
        acc[ai][bj][m][n] = __builtin_amdgcn_mfma_f32_16x16x32_bf16(Bt[n][k], At[m][k], acc[ai][bj][m][n], 0, 0, 0); __builtin_amdgcn_s_setprio(0); } while (0)
#define PG8_WAIT_V(n) asm volatile("s_waitcnt vmcnt(" #n ")" ::: "memory")
#define PG8_WAIT_L(n) asm volatile("s_waitcnt lgkmcnt(" #n ")" ::: "memory")
#define PG8_BAR __builtin_amdgcn_s_barrier()
#define PG8_SCHED __builtin_amdgcn_sched_barrier(0)
    Unit cur, nxt; int ui = 0;
#define PG8_NEXT(i, u, ok) do { unsigned ko_; unsigned cd_ = S.code(i, ko_); cd_ = (unsigned)__builtin_amdgcn_readfirstlane((int)cd_); ko_ = (unsigned)__builtin_amdgcn_readfirstlane((int)ko_); \
        ok = (cd_ >> 31) != 0u; if (ok) { (u).pn = (int)(cd_ & 255u); (u).pm = (int)((cd_ >> 8) & 255u); (u).nk = (int)((cd_ >> 16) & 255u); (u).ks = (int)((cd_ >> 24) & 15u); (u).ko = (int)ko_; } } while (0)
    bool ok0_; cur.pm = 0; cur.pn = 0; cur.ko = 0; cur.nk = 4; cur.ks = 0; PG8_NEXT(0, cur, ok0_);
    if (!ok0_) return;
    f32x4 acc[2][2][4][2];
#pragma unroll
    for (int a = 0; a < 2; ++a)
#pragma unroll
        for (int b = 0; b < 2; ++b)
#pragma unroll
            for (int m = 0; m < 4; ++m)
#pragma unroll
                for (int n = 0; n < 2; ++n) acc[a][b][m][n] = (f32x4){0.f, 0.f, 0.f, 0.f};
    bf16x8 At[4][2], B0[2][2], B1[2][2];
    const char* cA = (const char*)g.A + (size_t)cur.pm * tstepA + (size_t)cur.ko * 2; const char* cB = (const char*)g.Bt + (size_t)cur.pn * tstepB + (size_t)cur.ko * 2;
    S.a_ready(cur);
    if constexpr (SP2) {
        PG8_STAGE(PG8_SB(0, 0), cB, voffB); PG8_STAGE(PG8_SB(0, 1), cB + hstepB, voffB); PG8_STAGE(PG8_SA(0, 0), cA, voffA); PG8_STAGE(PG8_SA(0, 1), cA + hstepA, voffA);
        if (wr == 1) PG8_BAR;
        PG8_WAIT_V(2); PG8_BAR;
        PG8_STAGE(PG8_SB(1, 0), cB + kstep, voffB); PG8_STAGE(PG8_SA(1, 0), cA + kstep, voffA); PG8_STAGE(PG8_SB(1, 1), cB + hstepB + kstep, voffB);
        PG8_WAIT_V(6); PG8_BAR;
    } else {
        PG8_STAGE(PG8_SB(0, 0), cB, voffB); PG8_STAGE(PG8_SA(0, 0), cA, voffA); PG8_STAGE(PG8_SB(0, 1), cB + hstepB, voffB); PG8_STAGE(PG8_SA(0, 1), cA + hstepA, voffA);
        if (wr == 1) PG8_BAR;
        PG8_WAIT_V(4); PG8_BAR;
        PG8_STAGE(PG8_SB(1, 0), cB + kstep, voffB); PG8_STAGE(PG8_SA(1, 0), cA + kstep, voffA); PG8_STAGE(PG8_SB(1, 1), cB + hstepB + kstep, voffB);
        PG8_WAIT_V(6); PG8_BAR;
    }
    for (;;) {
        nxt = cur; bool has_next; PG8_NEXT(ui + 1, nxt, has_next);
        const char* nA = has_next ? (const char*)g.A + (size_t)nxt.pm * tstepA + (size_t)nxt.ko * 2 : cA; const char* nB = has_next ? (const char*)g.Bt + (size_t)nxt.pn * tstepB + (size_t)nxt.ko * 2 : cB;
        const int nt = __builtin_amdgcn_readfirstlane(cur.nk);
        for (int t = 0; t < nt; t += 2) {
            const bool last = (t == nt - 2);
            const char* a1 = cA + (size_t)(t + 1) * kstep;
            const char* a2 = last ? nA : cA + (size_t)(t + 2) * kstep; const char* b2 = last ? nB : cB + (size_t)(t + 2) * kstep;
            const char* a3 = a2 + kstep; const char* b3 = b2 + kstep;
            if (last && has_next) S.a_ready(nxt);
            if constexpr (SP2) {
            PG8_LDB(B0, 0, 0); PG8_LDB(B1, 0, 1); PG8_SCHED; PG8_LDA(At, 0, 0); PG8_STAGE(PG8_SA(1, 1), a1 + hstepA, voffA);
            PG8_WAIT_V(8); PG8_WAIT_L(0); PG8_BAR; PG8_MMA(0, 0, At, B0); PG8_MMA(0, 1, At, B1); PG8_BAR; PG8_SCHED;
            PG8_LDA(At, 0, 1); PG8_STAGE(PG8_SB(0, 0), b2, voffB); PG8_STAGE(PG8_SB(0, 1), b2 + hstepB, voffB); PG8_STAGE(PG8_SA(0, 0), a2, voffA);
            PG8_WAIT_V(8); PG8_WAIT_L(0); PG8_BAR; PG8_MMA(1, 0, At, B0); PG8_MMA(1, 1, At, B1); PG8_BAR; PG8_SCHED;
            PG8_LDB(B0, 1, 0); PG8_LDB(B1, 1, 1); PG8_SCHED; PG8_LDA(At, 1, 0); PG8_STAGE(PG8_SA(0, 1), a2 + hstepA, voffA);
            PG8_WAIT_V(8); PG8_WAIT_L(0); PG8_BAR; PG8_MMA(0, 0, At, B0); PG8_MMA(0, 1, At, B1); PG8_BAR; PG8_SCHED;
            PG8_LDA(At, 1, 1); PG8_STAGE(PG8_SB(1, 0), b3, voffB); PG8_STAGE(PG8_SB(1, 1), b3 + hstepB, voffB); PG8_STAGE(PG8_SA(1, 0), a3, voffA);
            PG8_WAIT_V(8); PG8_WAIT_L(0); PG8_BAR; PG8_MMA(1, 0, At, B0); PG8_MMA(1, 1, At, B1); PG8_BAR; PG8_SCHED;
            } else {
            PG8_LDB(B0, 0, 0); PG8_SCHED; PG8_LDA(At, 0, 0); PG8_STAGE(PG8_SA(1, 1), a1 + hstepA, voffA);
            PG8_WAIT_L(8); PG8_BAR; PG8_WAIT_L(0); PG8_MMA(0, 0, At, B0); PG8_BAR; PG8_SCHED;
            PG8_LDB(B1, 0, 1); PG8_STAGE(PG8_SB(0, 0), b2, voffB);
            PG8_BAR; PG8_WAIT_L(0); PG8_MMA(0, 1, At, B1); PG8_BAR;
            PG8_LDA(At, 0, 1); PG8_STAGE(PG8_SA(0, 0), a2, voffA);
            PG8_BAR; PG8_WAIT_L(0); PG8_MMA(1, 0, At, B0); PG8_BAR; PG8_SCHED;
            PG8_STAGE(PG8_SB(0, 1), b2 + hstepB, voffB);
            PG8_WAIT_V(6); PG8_BAR; PG8_MMA(1, 1, At, B1); PG8_BAR;
            PG8_LDB(B0, 1, 0); PG8_SCHED; PG8_LDA(At, 1, 0); PG8_STAGE(PG8_SA(0, 1), a2 + hstepA, voffA);
            PG8_WAIT_L(8); PG8_BAR; PG8_WAIT_L(0); PG8_MMA(0, 0, At, B0); PG8_BAR; PG8_SCHED;
            PG8_LDB(B1, 1, 1); PG8_STAGE(PG8_SB(1, 0), b3, voffB);
            PG8_BAR; PG8_WAIT_L(0); PG8_MMA(0, 1, At, B1); PG8_BAR;
            PG8_LDA(At, 1, 1); PG8_STAGE(PG8_SA(1, 0), a3, voffA);
            PG8_BAR; PG8_WAIT_L(0); PG8_MMA(1, 0, At, B0); PG8_BAR; PG8_SCHED;
            PG8_STAGE(PG8_SB(1, 1), b3 + hstepB, voffB);
            PG8_WAIT_V(6); PG8_BAR; PG8_MMA(1, 1, At, B1); PG8_BAR;
            }
        }
        if constexpr (ALIGN_EPI) { if (wr == 0) PG8_BAR; }
        if constexpr (!Epi::AFTER_DRAIN) { E(acc, cur, wr, wc, fr, fq); S.done(cur); }
        if (!has_next) break;
#pragma unroll
        for (int a = 0; a < 2; ++a)
#pragma unroll
            for (int b = 0; b < 2; ++b)
#pragma unroll
                for (int m = 0; m < 4; ++m)
#pragma unroll
                    for (int n = 0; n < 2; ++n) acc[a][b][m][n] = (f32x4){0.f, 0.f, 0.f, 0.f};
        cur = nxt; cA = nA; cB = nB; ++ui;
        if constexpr (ALIGN_EPI) { if (wr == 1) PG8_BAR; }
    }
    PG8_WAIT_V(0);
    if constexpr (!ALIGN_EPI) { if (wr == 0) PG8_BAR; }
    PG8_BAR;
    if constexpr (Epi::AFTER_DRAIN) { E.fused(acc, cur, wr, wc, fr, fq, lds, wid, lane); S.done(cur); }
#undef PG8_SA
#undef PG8_SB
#undef PG8_STAGE
#undef PG8_LDA
#undef PG8_LDB
#undef PG8_MMA
#undef PG8_WAIT_V
#undef PG8_WAIT_L
#undef PG8_BAR
#undef PG8_SCHED
}
}

typedef const f32x4 (&AccT)[2][2][4][2];
__device__ __forceinline__ void load_rinv(const float* RINV, int row0, float (&rinv)[2][4]) {
#pragma unroll
    for (int ai = 0; ai < 2; ++ai)
#pragma unroll
        for (int m = 0; m < 4; ++m) rinv[ai][m] = RINV[row0 + ai * 128 + m * 16];
}
struct EpiSwiglu {
    static constexpr bool PERM = true, AFTER_DRAIN = false;
    bf16_t* O; const float* RINV; const float* sw;
    __device__ __forceinline__ void operator()(AccT acc, const pg8::Unit& u, int wr, int wc, int fr, int fq) const {
        const int row0 = u.pm * 256 + wr * 64 + fr, bidx = u.pm < 64 ? (u.pm >> 4) : 4, l_ = fq * 16 + fr, st4 = ((l_ & 3) * 16 + (l_ >> 2)) * 4;
        bf16_t* obase = O + (size_t)(u.pm * 256 + wr * 64 + (l_ >> 2)) * DFF + u.pn * 128 + wc * 32 + (l_ & 3) * 8;
        float rinv[2][4]; load_rinv(RINV, row0, rinv);
        const float* swp = sw + (size_t)bidx * SWLD + u.pn * 256 + wc * 32 + 8 * fq;
        const f32x4 sa0 = *(const f32x4*)swp, sa1 = *(const f32x4*)(swp + 4), sb0 = *(const f32x4*)(swp + 128), sb1 = *(const f32x4*)(swp + 132);
#pragma unroll
        for (int ai = 0; ai < 2; ++ai)
#pragma unroll
            for (int m = 0; m < 4; ++m) { const float r = rinv[ai][m];
                const f32x4 a0 = acc[ai][0][m][0] * r + sa0, a1 = acc[ai][0][m][1] * r + sa1, b0 = acc[ai][1][m][0] * r + sb0, b1 = acc[ai][1][m][1] * r + sb1;
                u32x4 w;
                w.x = cvt_pk_bf16(silu(a0[0]) * b0[0], silu(a0[1]) * b0[1]); w.y = cvt_pk_bf16(silu(a0[2]) * b0[2], silu(a0[3]) * b0[3]);
                w.z = cvt_pk_bf16(silu(a1[0]) * b1[0], silu(a1[1]) * b1[1]); w.w = cvt_pk_bf16(silu(a1[2]) * b1[2], silu(a1[3]) * b1[3]);
                *(u32x4*)(obase + (size_t)(ai * 128 + m * 16) * DFF) = gather4(w, st4);
            }
    }
};
template <bool WZ, bool B32> struct EpiResid {
    static constexpr bool PERM = true, AFTER_DRAIN = false;
    hf_t* H; const void* baseL; const void* baseC;
    const float* gate;
    bf16_t* Z; const float* gnext; const float* scnext; float* SSQ; float coef, pad_;
    __device__ __forceinline__ void operator()(AccT acc, const pg8::Unit& u, int wr, int wc, int fr, int fq) const {
        const int row0 = u.pm * 256 + wr * 64 + fr, col0 = u.pn * 256 + wc * 32 + 8 * fq, lane = fq * 16 + fr;
        const int bidx = u.pm < 64 ? (u.pm >> 4) : 4;
        const float* gp = gate + (size_t)bidx * MODW + col0;
        f32x4 gv[2][2], gz[2][2];
#pragma unroll
        for (int bj = 0; bj < 2; ++bj)
#pragma unroll
            for (int n = 0; n < 2; ++n) { gv[bj][n] = *(const f32x4*)(gp + bj * 128 + n * 4) * coef;
                if (WZ) gz[bj][n] = *(const f32x4*)(gnext + col0 + bj * 128 + n * 4) * (*(const f32x4*)(scnext + (size_t)bidx * MODW + col0 + bj * 128 + n * 4) + 1.f); }
        const int st4 = ((lane & 3) * 16 + (lane >> 2)) * 4, ld4 = ((lane & 15) * 4 + (lane >> 4)) * 4;
        const size_t eo = (size_t)(u.pm * 256 + wr * 64 + (lane >> 2)) * LDP + u.pn * 256 + wc * 32 + (lane & 3) * 8;
        hf_t* hout = H + eo; bf16_t* zout = Z + eo; float ss[8];
        if constexpr (B32) {
            const float* base = (const float*)(u.pm < 64 ? baseL : baseC) + (size_t)row0 * D + col0;
            f32x4 hb[4][2][2];
#pragma unroll
            for (int ai = 0; ai < 2; ++ai) {
#pragma unroll
                for (int m = 0; m < 4; ++m)
#pragma unroll
                    for (int bj = 0; bj < 2; ++bj)
#pragma unroll
                        for (int n = 0; n < 2; ++n) hb[m][bj][n] = __builtin_nontemporal_load((const f32x4*)(base + (size_t)(ai * 128 + m * 16) * D + bj * 128 + n * 4));
                asm volatile("" ::: "memory");
#pragma unroll
                for (int m = 0; m < 4; ++m) { const size_t ro = (size_t)(ai * 128 + m * 16) * LDP; float t = 0.f;
#pragma unroll
                    for (int bj = 0; bj < 2; ++bj) { const f32x4 h0 = hb[m][bj][0] + gv[bj][0] * acc[ai][bj][m][0], h1 = hb[m][bj][1] + gv[bj][1] * acc[ai][bj][m][1];
                        const h16x4 q0 = __builtin_convertvector(h0, h16x4), q1 = __builtin_convertvector(h1, h16x4);
                        { const h16x8 hv8 = (h16x8){q0[0], q0[1], q0[2], q0[3], q1[0], q1[1], q1[2], q1[3]}; *(u32x4*)(hout + ro + bj * 128) = gather4(__builtin_bit_cast(u32x4, hv8), st4); }
                        t += ((h0[0] * h0[0] + h0[1] * h0[1]) + (h0[2] * h0[2] + h0[3] * h0[3])) + ((h1[0] * h1[0] + h1[1] * h1[1]) + (h1[2] * h1[2] + h1[3] * h1[3]));
                        if (WZ) { const f32x4 z0 = h0 * gz[bj][0], z1 = h1 * gz[bj][1]; u32x4 w; w.x = cvt_pk_bf16(z0[0], z0[1]); w.y = cvt_pk_bf16(z0[2], z0[3]); w.z = cvt_pk_bf16(z1[0], z1[1]); w.w = cvt_pk_bf16(z1[2], z1[3]);
                            *(u32x4*)(zout + ro + bj * 128) = gather4(w, st4); } }
                    ss[ai * 4 + m] = t; }
                asm volatile("" ::: "memory");
            }
        } else {
            const hf_t* base = (const hf_t*)(u.pm < 64 ? baseL : baseC) + eo;
            h16x8 hb[4][2];
#pragma unroll
            for (int ai = 0; ai < 2; ++ai) {
#pragma unroll
                for (int m = 0; m < 4; ++m)
#pragma unroll
                    for (int bj = 0; bj < 2; ++bj) hb[m][bj] = *(const h16x8*)(base + (size_t)(ai * 128 + m * 16) * LDP + bj * 128);
                asm volatile("" ::: "memory");
#pragma unroll
                for (int m = 0; m < 4; ++m) { const size_t ro = (size_t)(ai * 128 + m * 16) * LDP; float t = 0.f;
#pragma unroll
                    for (int bj = 0; bj < 2; ++bj) { const h16x8 b8 = __builtin_bit_cast(h16x8, gather4(__builtin_bit_cast(u32x4, hb[m][bj]), ld4));
                        const f32x4 h0 = (f32x4){(float)b8[0], (float)b8[1], (float)b8[2], (float)b8[3]} + gv[bj][0] * acc[ai][bj][m][0], h1 = (f32x4){(float)b8[4], (float)b8[5], (float)b8[6], (float)b8[7]} + gv[bj][1] * acc[ai][bj][m][1];
                        const h16x4 q0 = __builtin_convertvector(h0, h16x4), q1 = __builtin_convertvector(h1, h16x4);
                        { const h16x8 hv8 = (h16x8){q0[0], q0[1], q0[2], q0[3], q1[0], q1[1], q1[2], q1[3]}; *(u32x4*)(hout + ro + bj * 128) = gather4(__builtin_bit_cast(u32x4, hv8), st4); }
                        t += ((h0[0] * h0[0] + h0[1] * h0[1]) + (h0[2] * h0[2] + h0[3] * h0[3])) + ((h1[0] * h1[0] + h1[1] * h1[1]) + (h1[2] * h1[2] + h1[3] * h1[3]));
                        if (WZ) { const f32x4 z0 = h0 * gz[bj][0], z1 = h1 * gz[bj][1]; u32x4 w; w.x = cvt_pk_bf16(z0[0], z0[1]); w.y = cvt_pk_bf16(z0[2], z0[3]); w.z = cvt_pk_bf16(z1[0], z1[1]); w.w = cvt_pk_bf16(z1[2], z1[3]);
                            *(u32x4*)(zout + ro + bj * 128) = gather4(w, st4); } }
                    ss[ai * 4 + m] = t; }
                asm volatile("" ::: "memory");
            }
        }
#pragma unroll
        for (int g = 0; g < 8; ++g) { float t = ss[g]; t += xlane(t, lane ^ 16); t += xlane(t, lane ^ 32);
            if (fq == 0) SSQ[(size_t)(row0 + (g >> 2) * 128 + (g & 3) * 16) * 32 + u.pn * 4 + wc] = t; }
    }
};
struct EpiU {
    static constexpr bool PERM = true, AFTER_DRAIN = false;
    bf16_t* U; const float* RINV; const float* sw;
    __device__ __forceinline__ void operator()(AccT acc, const pg8::Unit& u, int wr, int wc, int fr, int fq) const {
        const int row0 = u.pm * 256 + wr * 64 + fr, col0 = u.pn * 256 + wc * 32 + 8 * fq, bidx = u.pm < 64 ? (u.pm >> 4) : 4, l_ = fq * 16 + fr, st4 = ((l_ & 3) * 16 + (l_ >> 2)) * 4;
        bf16_t* obase = U + (size_t)(u.pm * 256 + wr * 64 + (l_ >> 2)) * INCP + u.pn * 256 + wc * 32 + (l_ & 3) * 8;
        float rinv[2][4]; load_rinv(RINV, row0, rinv);
        const float* swp = sw + (size_t)bidx * SWLD + col0;
        f32x4 sv[2][2];
#pragma unroll
        for (int bj = 0; bj < 2; ++bj) { sv[bj][0] = *(const f32x4*)(swp + bj * 128); sv[bj][1] = *(const f32x4*)(swp + bj * 128 + 4); }
#pragma unroll
        for (int ai = 0; ai < 2; ++ai)
#pragma unroll
            for (int m = 0; m < 4; ++m) { const float r = rinv[ai][m]; bf16_t* rowp = obase + (size_t)(ai * 128 + m * 16) * INCP;
#pragma unroll
                for (int bj = 0; bj < 2; ++bj) { const f32x4 v0 = acc[ai][bj][m][0] * r + sv[bj][0], v1 = acc[ai][bj][m][1] * r + sv[bj][1];
                    u32x4 w; w.x = cvt_pk_bf16(v0[0], v0[1]); w.y = cvt_pk_bf16(v0[2], v0[3]); w.z = cvt_pk_bf16(v1[0], v1[1]); w.w = cvt_pk_bf16(v1[2], v1[3]);
                    *(u32x4*)(rowp + bj * 128) = gather4(w, st4); } }
    }
};
struct EpiPartial {
    static constexpr bool PERM = true, AFTER_DRAIN = false;
    hf_t* P; int N;
    __device__ __forceinline__ void operator()(AccT acc, const pg8::Unit& u, int wr, int wc, int fr, int fq) const {
        const int ks = u.ks, l_ = fq * 16 + fr, st4 = ((l_ & 3) * 16 + (l_ >> 2)) * 4;
        hf_t* base = P + ((size_t)ks * RC + (u.pm - 64) * 256 + wr * 64 + (l_ >> 2)) * N + u.pn * 256 + wc * 32 + (l_ & 3) * 8;
#pragma unroll
        for (int ai = 0; ai < 2; ++ai)
#pragma unroll
            for (int m = 0; m < 4; ++m) { hf_t* rowp = base + (size_t)(ai * 128 + m * 16) * N;
#pragma unroll
                for (int bj = 0; bj < 2; ++bj) { const h16x4 q0 = __builtin_convertvector(acc[ai][bj][m][0], h16x4), q1 = __builtin_convertvector(acc[ai][bj][m][1], h16x4);
                    const h16x8 hv8 = (h16x8){q0[0], q0[1], q0[2], q0[3], q1[0], q1[1], q1[2], q1[3]}; *(u32x4*)(rowp + bj * 128) = gather4(__builtin_bit_cast(u32x4, hv8), st4); } }
    }
};
template <class EA> struct EpiMix {
    static constexpr bool PERM = true, AFTER_DRAIN = false, PF = false;
    EA a; EpiPartial b;
    __device__ __forceinline__ void operator()(AccT acc, const pg8::Unit& u, int wr, int wc, int fr, int fq) const { if (u.pm < 64) a(acc, u, wr, wc, fr, fq); else b(acc, u, wr, wc, fr, fq); }
};
struct EpiUq {
    static constexpr bool PERM = true, AFTER_DRAIN = false;
    bf16_t* QB; const float* cosB; const float* sinB;
    __device__ __forceinline__ void operator()(AccT acc, const pg8::Unit& u, int wr, int wc, int fr, int fq) const {
        const int row0 = u.pm * 256 + wr * 64 + fr, l_ = fq * 16 + fr, st4 = ((l_ & 3) * 16 + (l_ >> 2)) * 4;
        bf16_t* obase = QB + (size_t)(u.pm * 256 + wr * 64 + (l_ >> 2)) * 768 + u.pn * 256 + wc * 32 + (l_ & 3) * 8;
        const bool lat = u.pm < 64;
#pragma unroll
        for (int bj = 0; bj < 2; ++bj) {
            const int col0 = u.pn * 256 + bj * 128 + wc * 32 + 8 * fq;
            const int within = col0 % 192; const bool rope = lat && within >= 128; const int j0 = (within - 128) >> 1;
#pragma unroll
            for (int ai = 0; ai < 2; ++ai)
#pragma unroll
                for (int m = 0; m < 4; ++m) {
                    const int row = row0 + ai * 128 + m * 16;
                    f32x4 v0 = acc[ai][bj][m][0], v1 = acc[ai][bj][m][1];
                    if (rope) {
                        const int t = row & 4095, pr = t >> 6, pc = t & 63;
                        float x[8] = {v0[0], v0[1], v0[2], v0[3], v1[0], v1[1], v1[2], v1[3]};
#pragma unroll
                        for (int q = 0; q < 4; ++q) { const int j = j0 + q; const int idx = j < 16 ? pr * 16 + j : pc * 16 + (j - 16); const float c = cosB[idx], s = sinB[idx];
                            const float a = x[2 * q], b = x[2 * q + 1]; x[2 * q] = a * c - b * s; x[2 * q + 1] = a * s + b * c; }
                        v0 = (f32x4){x[0], x[1], x[2], x[3]}; v1 = (f32x4){x[4], x[5], x[6], x[7]};
                    }
                    u32x4 w; w.x = cvt_pk_bf16(v0[0], v0[1]); w.y = cvt_pk_bf16(v0[2], v0[3]); w.z = cvt_pk_bf16(v1[0], v1[1]); w.w = cvt_pk_bf16(v1[2], v1[3]);
                    *(u32x4*)(obase + (size_t)(ai * 128 + m * 16) * 768 + bj * 128) = gather4(w, st4);
                }
        }
    }
};
struct EpiUkv {
    static constexpr bool PERM = true, AFTER_DRAIN = false;
    bf16_t* KB; bf16_t* VB;
    __device__ __forceinline__ void operator()(AccT acc, const pg8::Unit& u, int wr, int wc, int fr, int fq) const {
        const int l_ = fq * 16 + fr, st4 = ((l_ & 3) * 16 + (l_ >> 2)) * 4, row0 = u.pm * 256 + wr * 64 + (l_ >> 2), c0 = wc * 32 + (l_ & 3) * 8;
#pragma unroll
        for (int ai = 0; ai < 2; ++ai)
#pragma unroll
            for (int m = 0; m < 4; ++m) {
                const int row = row0 + ai * 128 + m * 16;
                size_t kvrow; if (row < RL) kvrow = (size_t)(row >> 12) * SKV + CTXL + (row & 4095); else { const int rc = row - RL; kvrow = (size_t)(rc >> 8) * SKV + (rc & 255); }
#pragma unroll
                for (int bj = 0; bj < 2; ++bj) { const f32x4 v0 = acc[ai][bj][m][0], v1 = acc[ai][bj][m][1];
                    u32x4 w; w.x = cvt_pk_bf16(v0[0], v0[1]); w.y = cvt_pk_bf16(v0[2], v0[3]); w.z = cvt_pk_bf16(v1[0], v1[1]); w.w = cvt_pk_bf16(v1[2], v1[3]);
                    w = gather4(w, st4);
                    if (bj == 0) *(u32x4*)(KB + kvrow * 768 + u.pn * 192 + c0) = w; else *(u32x4*)(VB + kvrow * 512 + u.pn * 128 + c0) = w; }
            }
    }
};
struct EpiPool {
    static constexpr bool PERM = true, AFTER_DRAIN = false;
    bf16_t* Y;
    __device__ __forceinline__ void operator()(AccT acc, const pg8::Unit& u, int wr, int wc, int fr, int fq) const {
        const int l_ = fq * 16 + fr, st4 = ((l_ & 3) * 16 + (l_ >> 2)) * 4, row0 = u.pm * 256 + wr * 64 + (l_ >> 2), col0 = 1536 + u.pn * 256 + wc * 32 + (l_ & 3) * 8;
#pragma unroll
        for (int ai = 0; ai < 2; ++ai)
#pragma unroll
            for (int m = 0; m < 4; ++m)
#pragma unroll
                for (int bj = 0; bj < 2; ++bj) { const f32x4 v0 = acc[ai][bj][m][0], v1 = acc[ai][bj][m][1];
                    u32x4 w; w.x = cvt_pk_bf16(v0[0], v0[1]); w.y = cvt_pk_bf16(v0[2], v0[3]); w.z = cvt_pk_bf16(v1[0], v1[1]); w.w = cvt_pk_bf16(v1[2], v1[3]);
                    *(u32x4*)(Y + (size_t)(row0 + ai * 128 + m * 16) * LDP + col0 + bj * 128) = gather4(w, st4); }
    }
};

struct Params { const float* in[22]; float* out; unsigned char* ws; };
enum { I_X = 0, I_C, I_CTX, I_CCTX, I_WMOD, I_BMOD, I_NORMG, I_F1IN, I_F1OUT, I_WIN, I_AQG, I_AKG, I_BQG, I_BKVG, I_WUQ, I_WUKV, I_WPOOL, I_CSCALE, I_WOUT, I_F2IN, I_F2OUT, I_FINALG };

__device__ __forceinline__ void p0_tables(float* tab, const int wv) {
    for (int i = tid_of(wv); i < 64 * 32 + 64 * 16; i += 512) {
        if (i < 64 * 32) { const int p = i >> 5, f = i & 31; const float inv = powf(10000.f, -(float)f / 32.f), ang = (float)p * inv; tab[i] = cosf(ang); tab[2048 + i] = sinf(ang); }
        else { const int k = i - 2048, p = k >> 4, f = k & 15; const float inv = powf(10000.f, -(float)f / 16.f), ang = (float)p * inv; tab[4096 + k] = cosf(ang); tab[4096 + 1024 + k] = sinf(ang); }
    }
}
__device__ __forceinline__ void p0_mod(const Params& p, float* MOD, float* lds_f, const int wv) {
    float* act = lds_f; float* red = lds_f + 5 * D;
    const int tid = tid_of(wv);
    for (int i = tid; i < 5 * D; i += 512) { const int r = i >> 11, k = i & 2047; const float v = r < 4 ? p.in[I_C][r * D + k] : p.in[I_CCTX][k]; act[i] = silu(v); }
    __syncthreads();
    const int cg = tid & 31, ks = tid >> 5;
    for (int item = blockIdx.x; item < 2 * 144; item += gridDim.x) {
        const int layer = item / 144, n0 = (item % 144) * 128;
        const float* W = p.in[I_WMOD] + (size_t)layer * D * MODW + n0 + cg * 4;
        f32x4 acc[5];
#pragma unroll
        for (int r = 0; r < 5; ++r) acc[r] = (f32x4){0.f, 0.f, 0.f, 0.f};
        for (int k = ks * 128; k < ks * 128 + 128; k += 8) {
            f32x4 w[8];
#pragma unroll
            for (int j = 0; j < 8; ++j) w[j] = __builtin_nontemporal_load((const f32x4*)(W + (size_t)(k + j) * MODW));
#pragma unroll
            for (int j = 0; j < 8; ++j)
#pragma unroll
                for (int r = 0; r < 5; ++r) acc[r] = acc[r] + w[j] * act[r * D + k + j];
        }
#pragma unroll
        for (int r = 0; r < 5; ++r) *(f32x4*)(red + (ks * 32 + cg) * 20 + r * 4) = acc[r];
        __syncthreads();
        for (int o = tid; o < 640; o += 512) { const int r = o >> 7, col = o & 127, cg2 = col >> 2, e = col & 3; float s = 0.f;
#pragma unroll
            for (int q = 0; q < 16; ++q) s += red[(q * 32 + cg2) * 20 + r * 4 + e];
            MOD[(size_t)(layer * 5 + r) * MODW + n0 + col] = s + p.in[I_BMOD][layer * MODW + n0 + col]; }
        __syncthreads();
    }
}
__device__ __forceinline__ void cvt_matrix(const float* __restrict__ src, int K, int N, bf16_t* __restrict__ dst, int kind, int& base, float* lds_f, const int wv) {
    const int tid = tid_of(wv), G = gridDim.x, nkt = K / 256, nnb = N / 64, ntiles = nkt * nnb;
    const int b_ = blockIdx.x, PER = 3 * G + (G - 32);
    for (int q_ = base / PER; q_ * PER < base + ntiles; ++q_)
    for (int sl_ = 0; sl_ < 4; ++sl_) {
        if (sl_ == 3 && b_ < 32) continue;
        const int g_ = q_ * PER + (sl_ < 3 ? b_ + G * sl_ : 3 * G + b_ - 32), t = g_ - base;
        if (t < 0 || t >= ntiles) continue;
        const int kt = t / nnb, nb = t % nnb, k0 = kt * 256, n0 = nb * 64;
        int drow0 = n0, perm = 0;
        if (kind == 1) { if (n0 < DFF) drow0 = 256 * (n0 >> 7) + (n0 & 127); else { const int n1 = n0 - DFF; drow0 = 256 * (n1 >> 7) + 128 + (n1 & 127); } }
        if (kind == 2) perm = (n0 % 192) == 128;
        { const int c4 = tid & 15, kr = tid >> 4;
          f32x4 v[8];
#pragma unroll
          for (int i = 0; i < 8; ++i) v[i] = __builtin_nontemporal_load((const f32x4*)(src + (size_t)(k0 + kr + 32 * i) * N + n0 + 4 * c4));
#pragma unroll
          for (int i = 0; i < 8; ++i) { float* l = lds_f + (kr + 32 * i) * 65 + 4 * c4; l[0] = v[i][0]; l[1] = v[i][1]; l[2] = v[i][2]; l[3] = v[i][3]; } }
        __syncthreads();
#pragma unroll
        for (int j = 0; j < 4; ++j) { const int idx = tid + 512 * j, r = ((idx >> 6) & 3) * 16 + ((idx >> 2) & 15), kc = (idx >> 8) * 4 + (idx & 3);
            const int sc = perm ? ((r & 1) ? 32 + (r >> 1) : (r >> 1)) : r;
            const float* l = lds_f + (kc * 8) * 65 + sc;
            u32x4 w; w.x = cvt_pk_bf16(l[0], l[65]); w.y = cvt_pk_bf16(l[2 * 65], l[3 * 65]); w.z = cvt_pk_bf16(l[4 * 65], l[5 * 65]); w.w = cvt_pk_bf16(l[6 * 65], l[7 * 65]);
            *(u32x4*)(dst + (size_t)(drow0 + r) * K + k0 + kc * 8) = w; }
        __syncthreads();
    }
    base += ntiles;
}
__device__ __forceinline__ void p0_weights(const Params& p, float* lds_f, const int wv) {
    int base = 0;
    const size_t gt = (size_t)blockIdx.x * 512 + tid_of(wv), gs = (size_t)gridDim.x * 512;
    for (int l = 0; l < DEPTH; ++l) {
        unsigned char* wl = p.ws + WS_W + (size_t)l * W_LAYER;
        cvt_matrix(p.in[I_F1IN] + (size_t)l * D * 2 * DFF, D, 2 * DFF, (bf16_t*)(wl + W_F1IN), 1, base, lds_f, wv);
        cvt_matrix(p.in[I_F2IN] + (size_t)l * D * 2 * DFF, D, 2 * DFF, (bf16_t*)(wl + W_F2IN), 1, base, lds_f, wv);
        cvt_matrix(p.in[I_F1OUT] + (size_t)l * DFF * D, DFF, D, (bf16_t*)(wl + W_F1OUT), 0, base, lds_f, wv);
        cvt_matrix(p.in[I_F2OUT] + (size_t)l * DFF * D, DFF, D, (bf16_t*)(wl + W_F2OUT), 0, base, lds_f, wv);
        cvt_matrix(p.in[I_WIN] + (size_t)l * D * INC, D, INC, (bf16_t*)(wl + W_IN), 0, base, lds_f, wv);
        cvt_matrix(p.in[I_WOUT] + (size_t)l * D * D, D, D, (bf16_t*)(wl + W_OUT), 0, base, lds_f, wv);
        cvt_matrix(p.in[I_WUQ] + (size_t)l * 512 * 768, 512, 768, (bf16_t*)(wl + W_UQ), 2, base, lds_f, wv);
        cvt_matrix(p.in[I_WUKV] + (size_t)l * 256 * 1024, 256, 1024, (bf16_t*)(wl + W_UKV), 0, base, lds_f, wv);
        { u32x4* z = (u32x4*)((bf16_t*)(wl + W_IN) + (size_t)INC * D); const size_t nz = (size_t)(INCP - INC) * D / 8; for (size_t i = gt; i < nz; i += gs) z[i] = (u32x4){0u, 0u, 0u, 0u}; }
        { bf16_t* wp = (bf16_t*)(wl + W_PL); const float* src = p.in[I_WPOOL] + (size_t)l * 4 * 128 * 128; const float* sc = p.in[I_CSCALE] + l * 512;
          for (size_t i = gt; i < 512 * 512; i += gs) { const int n = (int)(i >> 9), k = (int)(i & 511), g = n >> 7, d = n & 127, g2 = k >> 7, c = k & 127;
              wp[i] = (g == g2) ? f2bf(src[(g * 128 + c) * 128 + d] * sc[n]) : (bf16_t)0; } }
    }
}
__device__ __forceinline__ void p0b_z0(const Params& p, const float* MOD, bf16_t* Z, float* SSQ, float* RINV, const int wv) {
    const int tidx = tid_of(wv), lane = tidx & 63, gw = blockIdx.x * 8 + (tidx >> 6), NGW = gridDim.x * 8;
    const f32x4* gp = (const f32x4*)p.in[I_NORMG] + lane;
    f32x4 cur[8];
    if (gw < R) { const f32x4* hp = (const f32x4*)(gw < RL ? p.in[I_X] + (size_t)gw * D : p.in[I_CTX] + (size_t)(gw - RL) * D) + lane;
#pragma unroll
        for (int j = 0; j < 8; ++j) cur[j] = __builtin_nontemporal_load(hp + 64 * j); }
    for (int row = gw; row < R; row += NGW) {
        const int bidx = row < RL ? (row >> 12) : 4, nrow = row + NGW;
        f32x4 nxt[8];
#pragma unroll
        for (int j = 0; j < 8; ++j) nxt[j] = cur[j];
        if (nrow < R) { const f32x4* hp = (const f32x4*)(nrow < RL ? p.in[I_X] + (size_t)nrow * D : p.in[I_CTX] + (size_t)(nrow - RL) * D) + lane;
#pragma unroll
            for (int j = 0; j < 8; ++j) nxt[j] = __builtin_nontemporal_load(hp + 64 * j); }
        const f32x4* sp = (const f32x4*)(MOD + (size_t)bidx * MODW + D) + lane;
        f32x4 gs[8];
#pragma unroll
        for (int j = 0; j < 8; ++j) gs[j] = gp[64 * j] * (sp[64 * j] + 1.f);
        asm volatile("" ::: "memory");
        float ss = 0.f;
#pragma unroll
        for (int j = 0; j < 8; ++j) ss += (cur[j][0] * cur[j][0] + cur[j][1] * cur[j][1]) + (cur[j][2] * cur[j][2] + cur[j][3] * cur[j][3]);
        ss = wave_sum(ss, lane);
        u32x2* op = (u32x2*)(Z + (size_t)row * LDP) + lane;
#pragma unroll
        for (int j = 0; j < 8; ++j) { const f32x4 o = cur[j] * gs[j]; u32x2 w; w.x = cvt_pk_bf16(o[0], o[1]); w.y = cvt_pk_bf16(o[2], o[3]); op[64 * j] = w; }
        if (lane < 32) SSQ[(size_t)row * 32 + lane] = lane == 0 ? ss : 0.f;
        if (lane == 0) RINV[row] = rsqrtf(ss * (1.f / D) + EPS);
#pragma unroll
        for (int j = 0; j < 8; ++j) cur[j] = nxt[j];
    }
}
typedef __bf16 bf16v2 __attribute__((ext_vector_type(2)));
#define DOT2(a, b, c) __builtin_amdgcn_fdot2_f32_bf16(__builtin_bit_cast(bf16v2, (unsigned)(a)), __builtin_bit_cast(bf16v2, (unsigned)(b)), (c), false)
#define DPP_ADD(v, CTRL) (v) += __uint_as_float(__builtin_amdgcn_update_dpp(0u, __float_as_uint(v), CTRL, 0xf, 0xf, true))
__device__ __forceinline__ void p0b_sw(const unsigned char* ws, const float* MOD, float* SW, float* lds_f, const int wv) {
    const int tidx = tid_of(wv), lane = tidx & 63, gw = blockIdx.x * 8 + (tidx >> 6), NGW = gridDim.x * 8, sub = lane & 15;
    bf16_t* sh16 = (bf16_t*)lds_f;
    __syncthreads();
    for (int i = tidx; i < DEPTH * 3 * 5 * D / 4; i += 512) { const int cb = i / (D / 4), k4 = i % (D / 4), c = cb / 5, b = cb % 5, l = c / 3, sidx = c % 3;
        const f32x4 v = *(const f32x4*)(MOD + (size_t)(l * 5 + b) * MODW + sidx * 3 * D + k4 * 4);
        u32x2 w; w.x = cvt_pk_bf16(v[0], v[1]); w.y = cvt_pk_bf16(v[2], v[3]); *(u32x2*)(sh16 + (size_t)cb * D + k4 * 4) = w; }
    __syncthreads();
    constexpr int G0 = 2 * DFF / 4, G1 = INCP / 4, GL = 2 * G0 + G1;
#pragma unroll 1
    for (int g = gw; g < DEPTH * GL; g += NGW) {
        const int l = g / GL, gl = g - l * GL, sidx = gl < G0 ? 0 : (gl < G0 + G1 ? 1 : 2), rg = gl - (sidx == 0 ? 0 : (sidx == 1 ? G0 : G0 + G1)), c = l * 3 + sidx;
        const bf16_t* W = (const bf16_t*)(ws + WS_W + (size_t)l * W_LAYER + (sidx == 0 ? W_F1IN : (sidx == 1 ? W_IN : W_F2IN)));
        const int n = rg * 4 + (lane >> 4); const bf16_t* wrow = W + (size_t)n * D + sub * 8; const bf16_t* sp0 = sh16 + (size_t)c * 5 * D + sub * 8;
        float acc[5] = {0.f, 0.f, 0.f, 0.f, 0.f};
#pragma unroll 8
        for (int i = 0; i < 16; ++i) { const u32x4 w8 = __builtin_nontemporal_load((const u32x4*)(wrow + i * 128));
#pragma unroll
            for (int b = 0; b < 5; ++b) { const u32x4 s8 = *(const u32x4*)(sp0 + b * D + i * 128);
                acc[b] = DOT2(w8.x, s8.x, acc[b]); acc[b] = DOT2(w8.y, s8.y, acc[b]); acc[b] = DOT2(w8.z, s8.z, acc[b]); acc[b] = DOT2(w8.w, s8.w, acc[b]); } }
#pragma unroll
        for (int b = 0; b < 5; ++b) { float t = acc[b]; DPP_ADD(t, 0xB1); DPP_ADD(t, 0x4E); DPP_ADD(t, 0x141); DPP_ADD(t, 0x140);
            if (sub == 0) SW[(size_t)(c * 5 + b) * SWLD + n] = t; }
    }
    __syncthreads();
}

__device__ __forceinline__ void rinv_phase(const float* SSQ, float* RINV, int nrows, const int wv) {
    const int tidx = tid_of(wv), lane = tidx & 63, gt = blockIdx.x * 512 + tidx, NT = gridDim.x * 512;
    for (int i = gt; i < nrows * 8; i += NT) { const f32x4 a = *(const f32x4*)(SSQ + (size_t)i * 4); float v = (a[0] + a[1]) + (a[2] + a[3]);
        v += xlane(v, lane ^ 1); v += xlane(v, lane ^ 2); v += xlane(v, lane ^ 4);
        if ((lane & 7) == 0) RINV[i >> 3] = rsqrtf(v * (1.f / D) + EPS); }
}
struct CombResid { int nks; const hf_t* P; const float* base32; const hf_t* base16; hf_t* H; const float* gate; bf16_t* Z; const float* gnext; const float* scnext; float* RINV; float coef; int wz; };
__device__ __forceinline__ void ctx_combine_resid(const CombResid& a, float* lds_f, const int wv) {
    const int tidx = tid_of(wv), lane = tidx & 63, w = tidx >> 6, half = w & 1;
    for (int r0 = blockIdx.x * 4; r0 < RC; r0 += gridDim.x * 4) { const int r = r0 + (w >> 1); const size_t ro = (size_t)(RL + r) * LDP; float ss = 0.f;
#pragma unroll
        for (int jj = 0; jj < 4; ++jj) { const int col = (half * 4 + jj) * 256 + lane * 4;
            f32x4 acc = __builtin_convertvector(*(const h16x4*)(a.P + (size_t)r * D + col), f32x4);
#pragma unroll
            for (int ks = 1; ks < 8; ++ks) if (ks < a.nks) acc = acc + __builtin_convertvector(*(const h16x4*)(a.P + ((size_t)ks * RC + r) * D + col), f32x4);
            const f32x4 bs = a.base32 ? *(const f32x4*)(a.base32 + (size_t)r * D + col) : __builtin_convertvector(*(const h16x4*)(a.base16 + ro + col), f32x4);
            const f32x4 hv = bs + *(const f32x4*)(a.gate + (size_t)4 * MODW + col) * a.coef * acc;
            *(h16x4*)(a.H + ro + col) = __builtin_convertvector(hv, h16x4); ss += (hv[0] * hv[0] + hv[1] * hv[1]) + (hv[2] * hv[2] + hv[3] * hv[3]);
            if (a.wz) { const f32x4 z = hv * *(const f32x4*)(a.gnext + col) * (*(const f32x4*)(a.scnext + (size_t)4 * MODW + col) + 1.f); u32x2 w; w.x = cvt_pk_bf16(z[0], z[1]); w.y = cvt_pk_bf16(z[2], z[3]); *(u32x2*)(a.Z + ro + col) = w; } }
        ss = wave_sum(ss, lane);
        __syncthreads();
        if (lane == 0) lds_f[w] = ss;
        __syncthreads();
        if (lane == 0 && half == 0) a.RINV[RL + r] = rsqrtf((lds_f[w] + lds_f[w + 1]) * (1.f / D) + EPS); }
}
__device__ __forceinline__ void ctx_combine_u(const hf_t* P, const float* RINV, const float* sw, bf16_t* U, const int wv) {
    const int tidx = tid_of(wv), lane = tidx & 63, w = tidx >> 6, half = w & 1;
    for (int r = blockIdx.x * 4 + (w >> 1); r < RC; r += gridDim.x * 4) { const float rinv = RINV[RL + r];
#pragma unroll
        for (int jj = 0; jj < INCP / 512; ++jj) { const int col = (half * (INCP / 512) + jj) * 256 + lane * 4;
            f32x4 acc = __builtin_convertvector(__builtin_nontemporal_load((const h16x4*)(P + (size_t)r * INCP + col)), f32x4);
#pragma unroll
            for (int ks = 1; ks < 4; ++ks) acc = acc + __builtin_convertvector(__builtin_nontemporal_load((const h16x4*)(P + ((size_t)ks * RC + r) * INCP + col)), f32x4);
            const f32x4 v = acc * rinv + *(const f32x4*)(sw + (size_t)4 * SWLD + col);
            u32x2 w; w.x = cvt_pk_bf16(v[0], v[1]); w.y = cvt_pk_bf16(v[2], v[3]); *(u32x2*)(U + (size_t)(RL + r) * INCP + col) = w; } }
}
__device__ __forceinline__ void final_phase(const hf_t* H, const float* SSQ, float* out, const float* g, const int wv) {
    const int tidx = tid_of(wv), lane = tidx & 63, gw = blockIdx.x * 8 + (tidx >> 6), NGW = gridDim.x * 8;
    const f32x4* gp = (const f32x4*)g + lane;
    h16x4 cur[8]; float cs = 0.f;
    if (gw < RL) { const h16x4* hp = (const h16x4*)(H + (size_t)gw * LDP) + lane;
#pragma unroll
        for (int j = 0; j < 8; ++j) cur[j] = __builtin_nontemporal_load(hp + 64 * j);
        cs = lane < 32 ? SSQ[(size_t)gw * 32 + lane] : 0.f; }
    for (int row = gw; row < RL; row += NGW) {
        h16x4 nxt[8]; float ns = 0.f;
#pragma unroll
        for (int j = 0; j < 8; ++j) nxt[j] = cur[j];
        if (row + NGW < RL) { const h16x4* hp = (const h16x4*)(H + (size_t)(row + NGW) * LDP) + lane;
#pragma unroll
            for (int j = 0; j < 8; ++j) nxt[j] = __builtin_nontemporal_load(hp + 64 * j);
            ns = lane < 32 ? SSQ[(size_t)(row + NGW) * 32 + lane] : 0.f; }
        asm volatile("" ::: "memory");
        const float rinv = rsqrtf(wave_sum(cs, lane) * (1.f / D) + EPS);
        f32x4* op = (f32x4*)(out + (size_t)row * D) + lane;
#pragma unroll
        for (int j = 0; j < 8; ++j) op[64 * j] = __builtin_convertvector(cur[j], f32x4) * rinv * gp[64 * j];
#pragma unroll
        for (int j = 0; j < 8; ++j) cur[j] = nxt[j];
        cs = ns;
    }
}
struct PrepArgs { const bf16_t* U; bf16_t *QA, *KA, *VA, *BQN, *BKVN, *KB, *POOLED; const float *aqg, *akg, *bqg, *bkvg; const float* tab; };
struct PrepRaw { unsigned q1[8], q2[8], k1[2], k2[2], r1, r2; u32x2 av, bkv; bf16x8 bq; float cA, sA, cB, sB; };
__device__ __forceinline__ void prep_load(PrepRaw& r, const PrepArgs& a, int row, int lane) {
    const bf16_t* u = a.U + (size_t)row * INCP;
#pragma unroll
    for (int h = 0; h < 8; ++h) { r.q1[h] = __builtin_nontemporal_load(u + U_AQ + h * 128 + lane); r.q2[h] = __builtin_nontemporal_load(u + U_AQ + h * 128 + 64 + lane); }
#pragma unroll
    for (int h = 0; h < 2; ++h) { r.k1[h] = __builtin_nontemporal_load(u + U_AK + h * 128 + lane); r.k2[h] = __builtin_nontemporal_load(u + U_AK + h * 128 + 64 + lane); }
    r.av = __builtin_nontemporal_load((const u32x2*)(u + U_AV + lane * 4)); r.bq = __builtin_nontemporal_load((const bf16x8*)(u + U_BQ + lane * 8)); r.bkv = __builtin_nontemporal_load((const u32x2*)(u + U_BKV + lane * 4));
    r.r1 = u[U_BKR + (lane & 31)]; r.r2 = u[U_BKR + 32 + (lane & 31)];
    r.cA = 1.f; r.sA = 0.f; r.cB = 1.f; r.sB = 0.f;
    if (row < RL) { const int t = row & 4095, prow = t >> 6, pcol = t & 63; const float* cosA = a.tab; const float* sinA = a.tab + 2048; const float* cosB = a.tab + 4096; const float* sinB = a.tab + 4096 + 1024;
        const int ia = lane < 32 ? prow * 32 + lane : pcol * 32 + (lane - 32); r.cA = cosA[ia]; r.sA = sinA[ia];
        const int l5 = lane & 31, ib = l5 < 16 ? prow * 16 + l5 : pcol * 16 + (l5 - 16); r.cB = cosB[ib]; r.sB = sinB[ib]; }
}
__device__ __forceinline__ void prep_phase(const PrepArgs& a, const int wv) {
    const int tidx = tid_of(wv), lane = tidx & 63, gw = blockIdx.x * 8 + (tidx >> 6), NGW = gridDim.x * 8;
    { const float gq1 = a.aqg[lane], gq2 = a.aqg[64 + lane], gk1 = a.akg[lane], gk2 = a.akg[64 + lane];
      const f32x4 gb0 = *(const f32x4*)(a.bqg + lane * 8), gb1 = *(const f32x4*)(a.bqg + lane * 8 + 4), gkv = *(const f32x4*)(a.bkvg + lane * 4);
      PrepRaw cur; if (gw < R) prep_load(cur, a, gw, lane);
      for (int row = gw; row < R; row += NGW) {
        PrepRaw nxt = cur; if (row + NGW < R) prep_load(nxt, a, row + NGW, lane);
        asm volatile("" ::: "memory");
        size_t kvrow; if (row < RL) kvrow = (size_t)(row >> 12) * SKV + CTXL + (row & 4095); else { const int rc = row - RL; kvrow = (size_t)(rc >> 8) * SKV + (rc & 255); }
        const float cA = cur.cA, sA = cur.sA, cB = cur.cB, sB = cur.sB;
#pragma unroll
        for (int h = 0; h < 8; ++h) { const float x1 = bf2f((unsigned short)cur.q1[h]), x2 = bf2f((unsigned short)cur.q2[h]);
            const float rinv = rsqrtf(wave_sum(x1 * x1 + x2 * x2, lane) * (1.f / 128.f) + EPS); const float y1 = x1 * rinv * gq1, y2 = x2 * rinv * gq2;
            bf16_t* q = a.QA + (size_t)row * 1024 + h * 128; q[lane] = f2bf(y1 * cA - y2 * sA); q[64 + lane] = f2bf(y1 * sA + y2 * cA); }
#pragma unroll
        for (int h = 0; h < 2; ++h) { const float x1 = bf2f((unsigned short)cur.k1[h]), x2 = bf2f((unsigned short)cur.k2[h]);
            const float rinv = rsqrtf(wave_sum(x1 * x1 + x2 * x2, lane) * (1.f / 128.f) + EPS); const float y1 = x1 * rinv * gk1, y2 = x2 * rinv * gk2;
            bf16_t* k = a.KA + kvrow * 256 + h * 128; k[lane] = f2bf(y1 * cA - y2 * sA); k[64 + lane] = f2bf(y1 * sA + y2 * cA); }
        *(u32x2*)(a.VA + kvrow * 256 + lane * 4) = cur.av;
        { const bf16x8 q8 = cur.bq;
          const f32x4 v0 = {bf2f((unsigned short)q8[0]), bf2f((unsigned short)q8[1]), bf2f((unsigned short)q8[2]), bf2f((unsigned short)q8[3])}, v1 = {bf2f((unsigned short)q8[4]), bf2f((unsigned short)q8[5]), bf2f((unsigned short)q8[6]), bf2f((unsigned short)q8[7])};
          const float ss = (v0[0] * v0[0] + v0[1] * v0[1]) + (v0[2] * v0[2] + v0[3] * v0[3]) + (v1[0] * v1[0] + v1[1] * v1[1]) + (v1[2] * v1[2] + v1[3] * v1[3]);
          const float rinv = rsqrtf(wave_sum(ss, lane) * (1.f / 512.f) + EPS); const f32x4 o0 = v0 * rinv * gb0, o1 = v1 * rinv * gb1;
          u32x4 w; w.x = cvt_pk_bf16(o0[0], o0[1]); w.y = cvt_pk_bf16(o0[2], o0[3]); w.z = cvt_pk_bf16(o1[0], o1[1]); w.w = cvt_pk_bf16(o1[2], o1[3]);
          *(u32x4*)(a.BQN + (size_t)row * 512 + lane * 8) = w; }
        { const u32x2 k4 = cur.bkv; const f32x4 v = {__uint_as_float(k4.x << 16), __uint_as_float(k4.x & 0xffff0000u), __uint_as_float(k4.y << 16), __uint_as_float(k4.y & 0xffff0000u)};
          const float rinv = rsqrtf(wave_sum((v[0] * v[0] + v[1] * v[1]) + (v[2] * v[2] + v[3] * v[3]), lane) * (1.f / 256.f) + EPS);
          const f32x4 o = v * rinv * gkv; u32x2 w; w.x = cvt_pk_bf16(o[0], o[1]); w.y = cvt_pk_bf16(o[2], o[3]);
          *(u32x2*)(a.BKVN + (size_t)row * 256 + lane * 4) = w; }
        if (lane < 32) { const float x1 = bf2f((unsigned short)cur.r1), x2 = bf2f((unsigned short)cur.r2); const unsigned w = cvt_pk_bf16(x1 * cB - x2 * sB, x1 * sB + x2 * cB);
#pragma unroll
            for (int h = 0; h < 4; ++h) *(unsigned*)(a.KB + kvrow * 768 + h * 192 + 128 + 2 * lane) = w; }
        cur = nxt;
      } }
    { const int hw = 1 << (lane >> 4);
      for (int task = gw; task < R / 8; task += NGW) {
        const int row0 = task * 8; int t0, seqbase, L;
        if (row0 < RL) { t0 = row0 & 4095; seqbase = row0 - t0; L = SEQ; } else { const int rc = row0 - RL; t0 = rc & 255; seqbase = row0 - t0; L = CTXL; }
        bf16x8 xr[24];
#pragma unroll
        for (int jj = 0; jj < 24; ++jj) { int tj = t0 - 8 + jj; tj = tj < 0 ? 0 : (tj > L - 1 ? L - 1 : tj); xr[jj] = *(const bf16x8*)(a.U + (size_t)(seqbase + tj) * INCP + U_CU + lane * 8); }
#pragma unroll
        for (int i = 0; i < 8; ++i) { const int t = t0 + i; int lo = t - hw, hi = t + hw; lo = lo < 0 ? 0 : lo; hi = hi > L ? L : hi;
            float acc[8];
#pragma unroll
            for (int e = 0; e < 8; ++e) acc[e] = 0.f;
#pragma unroll
            for (int jj = i; jj < i + 16; ++jj) { const int tj = t0 - 8 + jj; const bool in = tj >= lo && tj < hi;
#pragma unroll
                for (int e = 0; e < 8; ++e) acc[e] += in ? bf2f((unsigned short)xr[jj][e]) : 0.f; }
            const float inv = 1.f / (float)(hi - lo); const bf16x8 c = xr[8 + i];
            u32x4 w; w.x = cvt_pk_bf16(acc[0] * inv - bf2f((unsigned short)c[0]), acc[1] * inv - bf2f((unsigned short)c[1])); w.y = cvt_pk_bf16(acc[2] * inv - bf2f((unsigned short)c[2]), acc[3] * inv - bf2f((unsigned short)c[3]));
            w.z = cvt_pk_bf16(acc[4] * inv - bf2f((unsigned short)c[4]), acc[5] * inv - bf2f((unsigned short)c[5])); w.w = cvt_pk_bf16(acc[6] * inv - bf2f((unsigned short)c[6]), acc[7] * inv - bf2f((unsigned short)c[7]));
            *(u32x4*)(a.POOLED + (size_t)(row0 + i) * 512 + lane * 8) = w; }
      } }
}
namespace att {
using f32x16 = __attribute__((ext_vector_type(16))) float;
using s16x4  = __attribute__((ext_vector_type(4))) short;
constexpr int QBLK = 32, KVBLK = 64, DV = 128;
constexpr float THR = 8.f;
constexpr int SHM_V = KVBLK * DV * 2;
#define SBAR() __builtin_amdgcn_sched_barrier(0)
__device__ __forceinline__ int crow(int r, int hi) { return (r & 3) + 8 * (r >> 2) + 4 * hi; }
template <int DK> struct Cst { static constexpr float SCALE = DK == 128 ? 0.088388347648318440f : 0.072168783648703220f; };
template <int DK>
__device__ __forceinline__ void partialSM(f32x16& p0, f32x16& p1, float& m_reg, float& mn, float& alpha) {
  constexpr float SCALE = Cst<DK>::SCALE, C = SCALE * 1.4426950408889634f;
  float pmax = p0[0];
#pragma unroll
  for (int r = 1; r < 16; ++r) pmax = fmaxf(pmax, p0[r]);
#pragma unroll
  for (int r = 0; r < 16; ++r) pmax = fmaxf(pmax, p1[r]);
  { auto rr = __builtin_amdgcn_permlane32_swap(__float_as_uint(pmax), __float_as_uint(pmax), false, false);
    pmax = fmaxf(__uint_as_float(rr[0]), __uint_as_float(rr[1])); }
  if (__builtin_expect(__all(pmax - m_reg <= THR / SCALE), 1)) { mn = m_reg; alpha = 1.f; }
  else { mn = fmaxf(m_reg, pmax); alpha = __builtin_amdgcn_exp2f((m_reg - mn) * C); m_reg = mn; }
  float mnC = -mn * C;
#pragma unroll
  for (int r = 0; r < 16; ++r) p0[r] = fmaf(p0[r], C, mnC);
#pragma unroll
  for (int r = 0; r < 16; ++r) p1[r] = fmaf(p1[r], C, mnC);
#pragma unroll
  for (int r = 0; r < 16; ++r) p0[r] = __builtin_amdgcn_exp2f(p0[r]);
}
__device__ __forceinline__ void finishSM(f32x16& p0, f32x16& p1, float alpha, float& l_reg, bf16x8& pa0, bf16x8& pa1, bf16x8& pa2, bf16x8& pa3) {
#pragma unroll
  for (int r = 0; r < 16; ++r) p1[r] = __builtin_amdgcn_exp2f(p1[r]);
  float ps = 0;
#pragma unroll
  for (int r = 0; r < 16; ++r) ps += p0[r];
#pragma unroll
  for (int r = 0; r < 16; ++r) ps += p1[r];
  { auto rr = __builtin_amdgcn_permlane32_swap(__float_as_uint(ps), __float_as_uint(ps), false, false);
    ps = __uint_as_float(rr[0]) + __uint_as_float(rr[1]); }
  l_reg = l_reg * alpha + ps;
#define PK4(P, BASE, OUT) do { unsigned a0 = cvt_pk_bf16(P[BASE + 0], P[BASE + 1]), a1 = cvt_pk_bf16(P[BASE + 2], P[BASE + 3]);   \
    unsigned b0 = cvt_pk_bf16(P[BASE + 4], P[BASE + 5]), b1 = cvt_pk_bf16(P[BASE + 6], P[BASE + 7]);                              \
    auto r0 = __builtin_amdgcn_permlane32_swap(a0, b0, false, false); auto r1 = __builtin_amdgcn_permlane32_swap(a1, b1, false, false); \
    u32x4 w = {r0[0], r1[0], r0[1], r1[1]}; OUT = *reinterpret_cast<bf16x8*>(&w); } while (0)
  PK4(p0, 0, pa0); PK4(p0, 8, pa1); PK4(p1, 0, pa2); PK4(p1, 8, pa3);
#undef PK4
}
template <int DK> __device__ __forceinline__ int kswz(int row, int colB) { return row * (DK * 2) + (colB ^ ((row & 7) << 4)); }
template <int DK, int NPARK>
__device__ __forceinline__ void qkt(f32x16& p0, f32x16& p1, const char* Ks, const bf16x8* qr, const char* qpark, int r32, int hi) {
  p0 = f32x16{}; p1 = f32x16{};
#pragma unroll
  for (int d0 = 0; d0 < DK / 16; ++d0) { const int cb = (d0 * 16 + hi * 8) * 2;
    bf16x8 b0 = *reinterpret_cast<const bf16x8*>(Ks + kswz<DK>(r32, cb));
    bf16x8 b1 = *reinterpret_cast<const bf16x8*>(Ks + kswz<DK>(32 + r32, cb));
    bf16x8 q;
    if constexpr (NPARK > 0) { if (d0 >= DK / 16 - NPARK) q = *reinterpret_cast<const bf16x8*>(qpark + (d0 - (DK / 16 - NPARK)) * 1024); else q = qr[d0]; } else q = qr[d0];
    p0 = __builtin_amdgcn_mfma_f32_32x32x16_bf16(b0, q, p0, 0, 0, 0);
    p1 = __builtin_amdgcn_mfma_f32_32x32x16_bf16(b1, q, p1, 0, 0, 0); }
}
__device__ __forceinline__ int v_st(int k, int c) { const int kk = (k & ~0xC) | ((k & 4) << 1) | ((k & 8) >> 1); return ((kk >> 3) * 4 + (c >> 5)) * 512 + ((kk & 7) * 32 + (c & 31)) * 2; }
__device__ __forceinline__ int v_rd_base(int lane) { return ((lane & 3) << 3) | (((lane >> 2) & 3) << 6) | (((lane >> 4) & 1) << 5) | (((lane >> 5) & 1) << 8); }
constexpr int v_rd_off(int d0, int ks, int half) { return d0 * 512 + ks * 4096 + half * 2048; }
template <int OFF> __device__ __forceinline__ s16x4 tr_read(int vb) {
  s16x4 r; asm volatile("ds_read_b64_tr_b16 %0, %1 offset:%2" : "=&v"(r) : "v"(vb), "i"(OFF) : "memory"); return r;
}
template <int D0> __device__ __forceinline__ void pv_one(f32x16& od, int vb, bf16x8 pa0, bf16x8 pa1, bf16x8 pa2, bf16x8 pa3) {
  const s16x4 l0 = tr_read<v_rd_off(D0, 0, 0)>(vb), h0 = tr_read<v_rd_off(D0, 0, 1)>(vb), l1 = tr_read<v_rd_off(D0, 1, 0)>(vb), h1 = tr_read<v_rd_off(D0, 1, 1)>(vb);
  const s16x4 l2 = tr_read<v_rd_off(D0, 2, 0)>(vb), h2 = tr_read<v_rd_off(D0, 2, 1)>(vb), l3 = tr_read<v_rd_off(D0, 3, 0)>(vb), h3 = tr_read<v_rd_off(D0, 3, 1)>(vb);
  asm volatile("s_waitcnt lgkmcnt(0)" ::: "memory"); SBAR();
#define PK(L, H) (bf16x8){L[0], L[1], L[2], L[3], H[0], H[1], H[2], H[3]}
  od = __builtin_amdgcn_mfma_f32_32x32x16_bf16(pa0, PK(l0, h0), od, 0, 0, 0);
  od = __builtin_amdgcn_mfma_f32_32x32x16_bf16(pa1, PK(l1, h1), od, 0, 0, 0);
  od = __builtin_amdgcn_mfma_f32_32x32x16_bf16(pa2, PK(l2, h2), od, 0, 0, 0);
  od = __builtin_amdgcn_mfma_f32_32x32x16_bf16(pa3, PK(l3, h3), od, 0, 0, 0);
#undef PK
}
__device__ __forceinline__ void pv_d0(f32x16* o, int vb, bf16x8 pa0, bf16x8 pa1, bf16x8 pa2, bf16x8 pa3) {
  pv_one<0>(o[0], vb, pa0, pa1, pa2, pa3); pv_one<1>(o[1], vb, pa0, pa1, pa2, pa3); pv_one<2>(o[2], vb, pa0, pa1, pa2, pa3); pv_one<3>(o[3], vb, pa0, pa1, pa2, pa3);
}
template <int DK, int LDQ, int LDK, int LDV, int LDO, int SDEPTH, int NPARK>
__device__ __forceinline__ void body(const bf16_t* __restrict__ Qb, const bf16_t* __restrict__ Kh, const bf16_t* __restrict__ Vh, bf16_t* __restrict__ Ob, int seq, char* lds, int tid, int wid) {
  constexpr int SHM_K = KVBLK * DK * 2, ND0 = DK / 16;
  const int lane = tid & 63, r32 = lane & 31, hi = lane >> 5;
  char* V_lds = lds; char* K_lds = lds + 2 * SHM_V;
  float* ws = (float*)(lds + 2 * SHM_V + 2 * SHM_K) + wid * 64; float* li_l = ws; float* al_l = ws + 32;
  float m_reg = -1e30f, l_reg = 0; f32x16 o[4] = {}; bf16x8 qr[ND0 - NPARK];
  const bf16_t* Qw = Qb + (long)(wid * QBLK + r32) * LDQ + hi * 8;
  char* qpark = lds + 2 * SHM_V + 2 * SHM_K + 2048 + wid * (NPARK * 1024) + lane * 16;
#pragma unroll
  for (int d0 = 0; d0 < ND0; ++d0) { const bf16x8 qv = *reinterpret_cast<const bf16x8*>(Qw + d0 * 16); if constexpr (NPARK > 0) { if (d0 >= ND0 - NPARK) *reinterpret_cast<bf16x8*>(qpark + (d0 - (ND0 - NPARK)) * 1024) = qv; else qr[d0] = qv; } else qr[d0] = qv; }
  const int sr = tid >> 4, sc = (tid & 15) * 8, vst0 = v_st(sr, sc), vst1 = v_st(32 + sr, sc);
  const int sr2 = tid >> 3, sc2 = 128 + (tid & 7) * 8;
  const int vb0 = (int)(uintptr_t)V_lds + v_rd_base(lane);
  struct { bf16x8 vs0, vs1, ks0, ks1, ks2; } sr_[SDEPTH];
  const unsigned ov0 = (unsigned)(sr * LDV + sc) * 2u, ov1 = (unsigned)((32 + sr) * LDV + sc) * 2u, ok0 = (unsigned)(sr * LDK + sc) * 2u, ok1 = (unsigned)((32 + sr) * LDK + sc) * 2u, ok2 = (unsigned)(sr2 * LDK + sc2) * 2u;
#define SLOAD(i, k0) do { const char* Vt_ = (const char*)Vh + (size_t)(k0) * (LDV * 2); const char* Kt_ = (const char*)Kh + (size_t)(k0) * (LDK * 2); \
    sr_[i].vs0 = *(const bf16x8*)(Vt_ + ov0); sr_[i].vs1 = *(const bf16x8*)(Vt_ + ov1); sr_[i].ks0 = *(const bf16x8*)(Kt_ + ok0); sr_[i].ks1 = *(const bf16x8*)(Kt_ + ok1); \
    if constexpr (DK == 192) sr_[i].ks2 = *(const bf16x8*)(Kt_ + ok2); } while (0)
#define SWRITE(b, i) do { *(bf16x8*)(V_lds + (b) * SHM_V + vst0) = sr_[i].vs0; *(bf16x8*)(V_lds + (b) * SHM_V + vst1) = sr_[i].vs1; const int kc = sc * 2; \
    *(bf16x8*)(K_lds + (b) * SHM_K + kswz<DK>(sr, kc)) = sr_[i].ks0; *(bf16x8*)(K_lds + (b) * SHM_K + kswz<DK>(32 + sr, kc)) = sr_[i].ks1; \
    if constexpr (DK == 192) *(bf16x8*)(K_lds + (b) * SHM_K + kswz<DK>(sr2, sc2 * 2)) = sr_[i].ks2; } while (0)
#define SWAIT() do { if constexpr (SDEPTH == 2) { if constexpr (DK == 192) asm volatile("s_waitcnt vmcnt(5)" ::: "memory"); else asm volatile("s_waitcnt vmcnt(4)" ::: "memory"); } else asm volatile("s_waitcnt vmcnt(0)" ::: "memory"); } while (0)
#define RESC(a) do { if (__any((a) < 1.f)) { if (hi == 0) al_l[r32] = (a); asm volatile("s_waitcnt lgkmcnt(0)" ::: "memory"); \
    _Pragma("unroll") for (int d = 0; d < 4; ++d) _Pragma("unroll") for (int r = 0; r < 16; ++r) o[d][r] *= al_l[crow(r, hi)]; } } while (0)
  f32x16 pA0, pA1, pB0, pB1; float mnA, mnB, alA, alB; bf16x8 pa0, pa1, pa2, pa3; const int NT = seq / KVBLK;
  constexpr int SE = 0, SO = SDEPTH - 1;
  SLOAD(SE, 0); asm volatile("s_waitcnt vmcnt(0)" ::: "memory"); SWRITE(0, SE); __syncthreads();
  qkt<DK, NPARK>(pA0, pA1, K_lds, qr, qpark, r32, hi); partialSM<DK>(pA0, pA1, m_reg, mnA, alA);
  SLOAD(SO, KVBLK); if constexpr (SDEPTH == 2) { if (2 < NT) SLOAD(SE, 2 * KVBLK); }
  SWAIT(); SWRITE(1, SO); __syncthreads();
  for (int j = 1; j + 1 < NT; j += 2) {
    SBAR(); qkt<DK, NPARK>(pB0, pB1, K_lds + SHM_K, qr, qpark, r32, hi);
    finishSM(pA0, pA1, alA, l_reg, pa0, pa1, pa2, pa3); SBAR();
    SLOAD(SO, (j + SDEPTH) * KVBLK); SBAR();
    pv_d0(o, vb0, pa0, pa1, pa2, pa3); partialSM<DK>(pB0, pB1, m_reg, mnB, alB);
    __syncthreads(); SWAIT(); SWRITE(0, SE);
    RESC(alB); __syncthreads();
    SBAR(); qkt<DK, NPARK>(pA0, pA1, K_lds, qr, qpark, r32, hi);
    finishSM(pB0, pB1, alB, l_reg, pa0, pa1, pa2, pa3); SBAR();
    if (SDEPTH == 1 || j + 3 < NT) SLOAD(SE, (j + 1 + SDEPTH) * KVBLK); SBAR();
    pv_d0(o, vb0 + (int)SHM_V, pa0, pa1, pa2, pa3); partialSM<DK>(pA0, pA1, m_reg, mnA, alA);
    __syncthreads(); SWAIT(); SWRITE(1, SO);
    RESC(alA); __syncthreads();
  }
  SBAR(); qkt<DK, NPARK>(pB0, pB1, K_lds + SHM_K, qr, qpark, r32, hi);
  finishSM(pA0, pA1, alA, l_reg, pa0, pa1, pa2, pa3); SBAR();
  pv_d0(o, vb0, pa0, pa1, pa2, pa3); partialSM<DK>(pB0, pB1, m_reg, mnB, alB);
  __syncthreads(); RESC(alB);
  finishSM(pB0, pB1, alB, l_reg, pa0, pa1, pa2, pa3); SBAR();
  pv_d0(o, vb0 + (int)SHM_V, pa0, pa1, pa2, pa3);
  if (hi == 0) li_l[r32] = l_reg; asm volatile("s_waitcnt lgkmcnt(0)" ::: "memory");
  float rli[16];
#pragma unroll
  for (int r = 0; r < 16; ++r) rli[r] = __builtin_amdgcn_rcpf(li_l[crow(r, hi)]);
  int r32e = r32, hie = hi; asm volatile("" : "+v"(r32e), "+v"(hie));
  bf16_t* Ow = Ob + (long)(wid * QBLK) * LDO;
#pragma unroll
  for (int r = 0; r < 16; ++r) { const int orow = crow(r, hie);
#pragma unroll
    for (int d0 = 0; d0 < 4; ++d0) Ow[(long)orow * LDO + d0 * 32 + r32e] = f2bf(o[d0][r] * rli[r]); }
#undef SLOAD
#undef SWRITE
#undef SWAIT
#undef RESC
}
static_assert(2 * SHM_V + 2 * KVBLK * 192 * 2 + 2048 + 8 * 8 * 1024 <= BAR_OFF, "MLA attention LDS fits below the barrier words");
}
struct AttnArgs { const bf16_t *QA, *KA, *VA, *QB, *KB, *VB; bf16_t* Y; };
__device__ __forceinline__ void attn_phase(const AttnArgs& a, bool ctxq, char* lds, const int wv) {
    const int tid = tid_of(wv), G = gridDim.x;
    const int nA = ctxq ? 544 : 512, nB = ctxq ? 272 : 256;
    for (int U = blockIdx.x; U < nA; U += G) {
        int b, hq, seq; long qrow;
        if (U < 512) { const int x = U & 7, j = (U >> 3) & 31, aa = (U >> 8) * 32 + j; b = x >> 1; hq = 4 * (x & 1) + (aa >> 4); qrow = (long)b * SEQ + (aa & 15) * 256; seq = SKV; }
        else { const int V = U - 512, x = V & 7; b = x >> 1; hq = 4 * (x & 1) + (V >> 3); qrow = (long)RL + b * CTXL; seq = CTXL; }
        const long kv = ((long)b * SKV) * 256 + (hq >> 2) * 128;
        att::body<128, 1024, 256, 256, LDP, 1, 0>(a.QA + qrow * 1024 + hq * 128, a.KA + kv, a.VA + kv, a.Y + qrow * LDP + hq * 128, seq, lds, opaque(tid), wv);
        __syncthreads();
    }
    for (int U = blockIdx.x; U < nB; U += G) {
        int b, h, seq; long qrow;
        if (U < 256) { const int x = U & 7, j = U >> 3; b = x >> 1; h = 2 * (x & 1) + (j >> 4); qrow = (long)b * SEQ + (j & 15) * 256; seq = SKV; }
        else { const int V = U - 256, x = V & 7; b = x >> 1; h = 2 * (x & 1) + (V >> 3); qrow = (long)RL + b * CTXL; seq = CTXL; }
        att::body<192, 768, 768, 512, LDP, 1, 4>(a.QB + qrow * 768 + h * 192, a.KB + ((long)b * SKV) * 768 + h * 192, a.VB + ((long)b * SKV) * 512 + h * 128, a.Y + qrow * LDP + 1024 + h * 128, seq, lds, opaque(tid), wv);
        __syncthreads();
    }
}

#ifndef REP_P0
#define REP_P0 0
#endif
#ifndef REP_THIN
#define REP_THIN 0
#endif
#ifndef REP_ATT
#define REP_ATT 0
#endif
#ifndef REP_FIN
#define REP_FIN 0
#endif
#ifndef REP_FOUT
#define REP_FOUT 0
#endif
#ifndef REP_MIX
#define REP_MIX 0
#endif
#define GEMM(g, S, E) pg8::gemm_phase<decltype(E), decltype(S), true, true>((LAS unsigned char*)lds, g, S, E, wv)
typedef const __attribute__((address_space(4))) Params* KParams;
__device__ __forceinline__ KParams kargs() { const __attribute__((address_space(4))) void* k = (const __attribute__((address_space(4))) void*)__builtin_amdgcn_kernarg_segment_ptr(); asm volatile("" : "+s"(k)); return (KParams)k; }
#define WSP(T, off) ((T*)(ws + (off)))
#define PH_BEGIN KParams kp = kargs(); unsigned char* ws = kp->ws; (void)ws; const int G = gridDim.x, bid = blockIdx.x; (void)G; (void)bid; \
    const unsigned char* wl = ws + WS_W + (size_t)layer * W_LAYER; (void)wl; const float* mod = WSP(float, WS_MOD) + (size_t)layer * 5 * MODW; (void)mod; pg8::StaticOrder S; (void)S;
__global__ void __launch_bounds__(512, 2) fwd_kernel(Params p) {
    extern __shared__ __attribute__((aligned(16))) unsigned char lds[];
    float* lds_f = (float*)lds;
    const int wv = __builtin_amdgcn_readfirstlane(threadIdx.x >> 6);
    if (threadIdx.x == 0) *(uint4*)(lds + BAR_OFF) = make_uint4(0u, 0u, 0u, 0u);
    __syncthreads();
    XcdBarrier bar = xcd_barrier_post((unsigned*)(p.ws + WS_CTL), (volatile LAS unsigned*)(lds + BAR_OFF));

    for (int rep = 0; rep <= REP_P0; ++rep)
    { unsigned char* ws = p.ws;
      if (blockIdx.x == 0) p0_tables(WSP(float, WS_TAB), wv);
      p0_mod(p, WSP(float, WS_MOD), lds_f, wv);
      __syncthreads();
      p0_weights(p, lds_f, wv); __syncthreads(); }
    xcd_barrier(bar, wv);
    for (int rep = 0; rep <= REP_P0; ++rep)
    { unsigned char* ws = p.ws;
      p0b_z0(p, WSP(float, WS_MOD), WSP(bf16_t, WS_XN), WSP(float, WS_SSQ), WSP(float, WS_RINV), wv);
      p0b_sw(ws, WSP(float, WS_MOD), WSP(float, WS_SW), lds_f, wv); }
    xcd_barrier(bar, wv);

#pragma unroll 1
    for (int layer = 0; layer < DEPTH; ++layer) {
        const int Mo = layer == 0 ? R : RL;
        { PH_BEGIN pg8::Gemm g{WSP(bf16_t, WS_XN), (const bf16_t*)(wl + W_F1IN), R, 2 * DFF, D, LDP, D}; S.init(R, 2 * DFF, G, bid, D);
            EpiSwiglu E{WSP(bf16_t, WS_ACT), WSP(float, WS_RINV), WSP(float, WS_SW) + (size_t)(layer * 3 + 0) * 5 * SWLD}; GEMM(g, S, E); }
        xcd_barrier(bar, wv);
        if (layer == 0) { PH_BEGIN pg8::Gemm g{WSP(bf16_t, WS_ACT), (const bf16_t*)(wl + W_F1OUT), R, D, DFF, DFF}; pg8::MixOrder MS; MS.init(D, DFF, 8, G, bid, true);
            EpiMix<EpiResid<true, true>> E{{WSP(hf_t, WS_H), kp->in[I_X], kp->in[I_X], mod + 2 * D, WSP(bf16_t, WS_XN), kp->in[I_NORMG] + (size_t)layer * 3 * D + D, mod + 4 * D, WSP(float, WS_SSQ), 0.5f, 0.f}, {WSP(hf_t, WS_PART), D}}; GEMM(g, MS, E); }
        else { PH_BEGIN pg8::Gemm g{WSP(bf16_t, WS_ACT), (const bf16_t*)(wl + W_F1OUT), R, D, DFF, DFF}; pg8::MixOrder MS; MS.init(D, DFF, 8, G, bid, true);
            EpiMix<EpiResid<true, false>> E{{WSP(hf_t, WS_H), WSP(hf_t, WS_H), WSP(hf_t, WS_H), mod + 2 * D, WSP(bf16_t, WS_XN), kp->in[I_NORMG] + (size_t)layer * 3 * D + D, mod + 4 * D, WSP(float, WS_SSQ), 0.5f, 0.f}, {WSP(hf_t, WS_PART), D}}; GEMM(g, MS, E); }
        xcd_barrier(bar, wv);
        { PH_BEGIN rinv_phase(WSP(float, WS_SSQ), WSP(float, WS_RINV), RL, wv);
            CombResid a{8, WSP(hf_t, WS_PART), layer == 0 ? kp->in[I_CTX] : nullptr, WSP(hf_t, WS_H), WSP(hf_t, WS_H), mod + 2 * D, WSP(bf16_t, WS_XN), kp->in[I_NORMG] + (size_t)layer * 3 * D + D, mod + 4 * D, WSP(float, WS_RINV), 0.5f, 1};
            ctx_combine_resid(a, (float*)lds, wv); }
        xcd_barrier(bar, wv);
        { PH_BEGIN pg8::Gemm g{WSP(bf16_t, WS_XN), (const bf16_t*)(wl + W_IN), R, INCP, D, LDP, D}; pg8::MixOrder MS; MS.init(INCP, D, 4, G, bid, true);
            EpiMix<EpiU> E{{WSP(bf16_t, WS_U), WSP(float, WS_RINV), WSP(float, WS_SW) + (size_t)(layer * 3 + 1) * 5 * SWLD}, {WSP(hf_t, WS_PART), INCP}}; GEMM(g, MS, E); }
        xcd_barrier(bar, wv);
        { PH_BEGIN ctx_combine_u(WSP(hf_t, WS_PART), WSP(float, WS_RINV), WSP(float, WS_SW) + (size_t)(layer * 3 + 1) * 5 * SWLD, WSP(bf16_t, WS_U), wv); }
        xcd_barrier(bar, wv);
        for (int rep = 0; rep <= REP_THIN; ++rep) { PH_BEGIN PrepArgs a{WSP(bf16_t, WS_U), WSP(bf16_t, WS_QA), WSP(bf16_t, WS_KA), WSP(bf16_t, WS_VA), WSP(bf16_t, WS_BQN), WSP(bf16_t, WS_BKVN), WSP(bf16_t, WS_KB), WSP(bf16_t, WS_POOL),
                              kp->in[I_AQG] + layer * 128, kp->in[I_AKG] + layer * 128, kp->in[I_BQG] + layer * 512, kp->in[I_BKVG] + layer * 256, WSP(float, WS_TAB)}; prep_phase(a, wv); }
        xcd_barrier(bar, wv);
        { PH_BEGIN pg8::Gemm g{WSP(bf16_t, WS_BQN), (const bf16_t*)(wl + W_UQ), R, 768, 512, 512}; S.init(R, 768, G, bid, 512); EpiUq E{WSP(bf16_t, WS_QB), WSP(float, WS_TAB) + 4096, WSP(float, WS_TAB) + 4096 + 1024}; GEMM(g, S, E); }
        { PH_BEGIN pg8::Gemm g{WSP(bf16_t, WS_BKVN), (const bf16_t*)(wl + W_UKV), R, 1024, 256, 256}; S.init(R, 1024, G, (bid + 204) % G, 256); EpiUkv E{WSP(bf16_t, WS_KB), WSP(bf16_t, WS_VB)}; GEMM(g, S, E); }
        { PH_BEGIN pg8::Gemm g{WSP(bf16_t, WS_POOL), (const bf16_t*)(wl + W_PL), R, 512, 512, 512}; S.init(R, 512, G, (bid + 220) % G, 512); EpiPool E{WSP(bf16_t, WS_Y)}; GEMM(g, S, E); }
        xcd_barrier(bar, wv);
        for (int rep = 0; rep <= REP_ATT; ++rep) { PH_BEGIN AttnArgs a{WSP(bf16_t, WS_QA), WSP(bf16_t, WS_KA), WSP(bf16_t, WS_VA), WSP(bf16_t, WS_QB), WSP(bf16_t, WS_KB), WSP(bf16_t, WS_VB), WSP(bf16_t, WS_Y)}; attn_phase(a, layer == 0, (char*)lds, wv); }
        xcd_barrier(bar, wv);
        { PH_BEGIN pg8::Gemm g{WSP(bf16_t, WS_Y), (const bf16_t*)(wl + W_OUT), R, D, D, LDP, D}; pg8::MixOrder MS; MS.init(D, D, 8, G, bid, layer == 0);
            EpiMix<EpiResid<true, false>> E{{WSP(hf_t, WS_H), WSP(hf_t, WS_H), WSP(hf_t, WS_H), mod + 5 * D, WSP(bf16_t, WS_XN), kp->in[I_NORMG] + (size_t)layer * 3 * D + 2 * D, mod + 7 * D, WSP(float, WS_SSQ), 1.0f, 0.f}, {WSP(hf_t, WS_PART), D}}; GEMM(g, MS, E); }
        xcd_barrier(bar, wv);
        { PH_BEGIN rinv_phase(WSP(float, WS_SSQ), WSP(float, WS_RINV), RL, wv);
            if (layer == 0) { CombResid a{8, WSP(hf_t, WS_PART), nullptr, WSP(hf_t, WS_H), WSP(hf_t, WS_H), mod + 5 * D, WSP(bf16_t, WS_XN), kp->in[I_NORMG] + (size_t)layer * 3 * D + 2 * D, mod + 7 * D, WSP(float, WS_RINV), 1.0f, 1};
                ctx_combine_resid(a, (float*)lds, wv); } }
        xcd_barrier(bar, wv);
        { PH_BEGIN pg8::Gemm g{WSP(bf16_t, WS_XN), (const bf16_t*)(wl + W_F2IN), Mo, 2 * DFF, D, LDP, D}; S.init(Mo, 2 * DFF, G, bid, D);
            EpiSwiglu E{WSP(bf16_t, WS_ACT), WSP(float, WS_RINV), WSP(float, WS_SW) + (size_t)(layer * 3 + 2) * 5 * SWLD}; GEMM(g, S, E); }
        xcd_barrier(bar, wv);
        if (layer + 1 < DEPTH) {
            { PH_BEGIN pg8::Gemm g{WSP(bf16_t, WS_ACT), (const bf16_t*)(wl + W_F2OUT), R, D, DFF, DFF}; pg8::MixOrder MS; MS.init(D, DFF, 8, G, bid, true);
                EpiMix<EpiResid<true, false>> E{{WSP(hf_t, WS_H), WSP(hf_t, WS_H), WSP(hf_t, WS_H), mod + 8 * D, WSP(bf16_t, WS_XN), kp->in[I_NORMG] + (size_t)(layer + 1) * 3 * D, mod + 5 * MODW + 1 * D, WSP(float, WS_SSQ), 0.5f, 0.f}, {WSP(hf_t, WS_PART), D}}; GEMM(g, MS, E); }
            xcd_barrier(bar, wv);
            { PH_BEGIN rinv_phase(WSP(float, WS_SSQ), WSP(float, WS_RINV), RL, wv);
                CombResid a{8, WSP(hf_t, WS_PART), nullptr, WSP(hf_t, WS_H), WSP(hf_t, WS_H), mod + 8 * D, WSP(bf16_t, WS_XN), kp->in[I_NORMG] + (size_t)(layer + 1) * 3 * D, mod + 5 * MODW + 1 * D, WSP(float, WS_RINV), 0.5f, 1};
                ctx_combine_resid(a, (float*)lds, wv); }
            xcd_barrier(bar, wv);
        } else {
            { PH_BEGIN pg8::Gemm g{WSP(bf16_t, WS_ACT), (const bf16_t*)(wl + W_F2OUT), RL, D, DFF, DFF}; S.init(RL, D, G, bid, DFF);
                EpiResid<false, false> E{WSP(hf_t, WS_H), WSP(hf_t, WS_H), WSP(hf_t, WS_H), mod + 8 * D, nullptr, nullptr, nullptr, WSP(float, WS_SSQ), 0.5f, 0.f}; GEMM(g, S, E); }
            xcd_barrier(bar, wv);
        }
    }
    for (int rep = 0; rep <= REP_THIN; ++rep) { const int layer = 0; PH_BEGIN final_phase(WSP(hf_t, WS_H), WSP(float, WS_SSQ), kp->out, kp->in[I_FINALG], wv); }
}

extern "C" void kernel_launch(void* const* d_in, const int* in_sizes, int n_in, void* d_out, int out_size, void* d_ws, size_t ws_size, hipStream_t stream) {
    static int grid = 0;
    if (grid == 0) {
        if (n_in != 22 || out_size != RL * D || ws_size < WS_END) { fprintf(stderr, "kernel_launch: shape mismatch: n_in %d out %d ws %zu (need %zu)\n", n_in, out_size, ws_size, (size_t)WS_END); grid = -1; return; }
        int dev = 0, cus = 0, per_cu = 0;
        if (hipGetDevice(&dev) != hipSuccess || hipDeviceGetAttribute(&cus, hipDeviceAttributeMultiprocessorCount, dev) != hipSuccess) { grid = -1; return; }
        if (hipFuncSetAttribute((const void*)fwd_kernel, hipFuncAttributeMaxDynamicSharedMemorySize, LDS_BYTES) != hipSuccess) { fprintf(stderr, "kernel_launch: hipFuncSetAttribute failed\n"); grid = -1; return; }
        if (hipOccupancyMaxActiveBlocksPerMultiprocessor(&per_cu, (const void*)fwd_kernel, 512, LDS_BYTES) != hipSuccess || per_cu < 1) { fprintf(stderr, "kernel_launch: occupancy query says %d\n", per_cu); }
        (void)hipGetLastError();
        grid = cus;
    }
    if (grid < 0) return;
    if (hipMemsetAsync((char*)d_ws + WS_CTL, 0, CTL_BYTES, stream) != hipSuccess) return;
    Params p{};
    for (int i = 0; i < 22; ++i) p.in[i] = (const float*)d_in[i];
    p.out = (float*)d_out; p.ws = (unsigned char*)d_ws;
    hipLaunchKernelGGL(fwd_kernel, dim3(grid), dim3(512), LDS_BYTES, stream, p);
}
```
